# Optimizing an MI355X kernel written in HIP

```python
import math
import jax, jax.numpy as jnp
from jax import lax
import numpy as np

D_MODEL = 2048
BATCH = 4
SEQ = 2048
DEPTH = 2
DEC_BATCH = 128
DEC_SEQ = 4
PAST_LEN = 16384
PAGE_SIZE = 128

N_MIXERS = 2
N_CONV_LAYERS = (DEPTH + 1) // 2
N_SSM_LAYERS = DEPTH // 2
N_META = 16
D_CONV = D_MODEL
CONV_WIDTH = 3
SSM_GROUP_WIDTH = 16
SSM_GROUPS = D_MODEL // SSM_GROUP_WIDTH
SSM_STATE = 64
D_FF = 4 * D_MODEL
NORM_EPS = 1e-6

kernel_name = "hybrid_shortconv_s5_decoder_step"


def rmsnorm(x, g):
    x32 = x.astype(jnp.float32)
    y = x32 * lax.rsqrt(jnp.mean(x32 * x32, axis=-1, keepdims=True) + NORM_EPS)
    return (y * g.astype(jnp.float32)).astype(x.dtype)


def short_conv_mixer(u, conv_past, w_in, w_conv, w_out):
    L = u.shape[1]
    proj = u @ w_in
    b_gate, c_gate, h = jnp.split(proj, 3, axis=-1)
    v = (c_gate * h).astype(conv_past.dtype)
    vp = jnp.concatenate([conv_past, v], axis=1)
    conv = (w_conv[0] * vp[:, 0:L] + w_conv[1] * vp[:, 1:L + 1]
            + w_conv[2] * vp[:, 2:L + 2])
    out = (b_gate * conv) @ w_out
    new_past = vp[:, L:]
    return out.astype(u.dtype), new_past


def _scan_combine(e1, e2):
    a1r, a1i, b1r, b1i = e1
    a2r, a2i, b2r, b2i = e2
    ar = a2r * a1r - a2i * a1i
    ai = a2r * a1i + a2i * a1r
    br = a2r * b1r - a2i * b1i + b2r
    bi = a2r * b1i + a2i * b1r + b2i
    return (ar, ai, br, bi)


def s5_mixer(u, h0_re, h0_im, lam_re, lam_im, log_step, b_re, b_im, c_re, c_im, d_skip, w_a, w_b):
    bsz, L, _ = u.shape
    u32 = u.astype(jnp.float32).reshape(bsz, L, SSM_GROUPS, SSM_GROUP_WIDTH)
    dt = jnp.exp(log_step.astype(jnp.float32))[:, None]
    lr = lam_re.astype(jnp.float32)
    li = lam_im.astype(jnp.float32)
    mag = jnp.exp(lr * dt)
    abar_re = mag * jnp.cos(li * dt)
    abar_im = mag * jnp.sin(li * dt)
    nr = abar_re - 1.0
    ni = abar_im
    den = lr * lr + li * li
    q_re = (nr * lr + ni * li) / den
    q_im = (ni * lr - nr * li) / den
    br32 = b_re.astype(jnp.float32)
    bi32 = b_im.astype(jnp.float32)
    bbar_re = q_re[..., None] * br32 - q_im[..., None] * bi32
    bbar_im = q_re[..., None] * bi32 + q_im[..., None] * br32
    bu_re = jnp.einsum('btgc,gpc->btgp', u32, bbar_re)
    bu_im = jnp.einsum('btgc,gpc->btgp', u32, bbar_im)
    a_re = jnp.broadcast_to(abar_re, (1, L, SSM_GROUPS, SSM_STATE))
    a_im = jnp.broadcast_to(abar_im, (1, L, SSM_GROUPS, SSM_STATE))
    cum_ar, cum_ai, cum_br, cum_bi = lax.associative_scan(
        _scan_combine, (a_re, a_im, bu_re, bu_im), axis=1)
    h0r = h0_re.astype(jnp.float32)[:, None]
    h0i = h0_im.astype(jnp.float32)[:, None]
    h_re = cum_ar * h0r - cum_ai * h0i + cum_br
    h_im = cum_ar * h0i + cum_ai * h0r + cum_bi
    y = (jnp.einsum('gcp,btgp->btgc', c_re.astype(jnp.float32), h_re)
         - jnp.einsum('gcp,btgp->btgc', c_im.astype(jnp.float32), h_im)
         + d_skip.astype(jnp.float32).reshape(SSM_GROUPS, SSM_GROUP_WIDTH) * u32)
    y = y.reshape(bsz, L, D_MODEL)
    g = jax.nn.gelu(y)
    out = (g @ w_a.astype(jnp.float32)) * jax.nn.sigmoid(g @ w_b.astype(jnp.float32))
    return out.astype(u.dtype), h_re[:, -1].astype(h0_re.dtype), h_im[:, -1].astype(h0_im.dtype)


def sq_relu_mlp(x, w_up, w_down):
    h = jax.nn.relu(x @ w_up)
    return (h * h) @ w_down


def trunk(h, conv_past, ssm_re0, ssm_im0, norm_mixer, norm_mlp, norm_final,
          conv_w_in, conv_w, conv_w_out,
          ssm_lambda_re, ssm_lambda_im, ssm_log_step, ssm_b_re, ssm_b_im,
          ssm_c_re, ssm_c_im, ssm_d, ssm_glu_w_a, ssm_glu_w_b,
          mlp_w_up, mlp_w_down):
    new_conv, new_re, new_im = [], [], []
    for i in range(DEPTH):
        j = i // N_MIXERS
        hn = rmsnorm(h, norm_mixer[i])
        if i % N_MIXERS == 0:
            m, st = short_conv_mixer(hn, conv_past[j], conv_w_in[j], conv_w[j], conv_w_out[j])
            new_conv.append(st)
        else:
            m, sr, si = s5_mixer(hn, ssm_re0[j], ssm_im0[j], ssm_lambda_re[j], ssm_lambda_im[j],
                                 ssm_log_step[j], ssm_b_re[j], ssm_b_im[j], ssm_c_re[j], ssm_c_im[j],
                                 ssm_d[j], ssm_glu_w_a[j], ssm_glu_w_b[j])
            new_re.append(sr)
            new_im.append(si)
        h = h + m
        h = h + sq_relu_mlp(rmsnorm(h, norm_mlp[i]), mlp_w_up[i], mlp_w_down[i])
    h = rmsnorm(h, norm_final)
    return h, jnp.stack(new_conv), jnp.stack(new_re), jnp.stack(new_im)


def setup_inputs(seed: int = 0) -> dict:
    key = jax.random.key(seed)
    ks = jax.random.split(key, 32)
    f32 = jnp.float32
    nrm = lambda k, s, sc: (jax.random.normal(k, s, f32) * sc)
    x_prompt = nrm(ks[0], (BATCH, SEQ, D_MODEL), 1.0)
    x_sample = nrm(ks[1], (DEC_BATCH, DEC_SEQ, D_MODEL), 1.0)
    state_conv = nrm(ks[2], (N_CONV_LAYERS, DEC_BATCH, CONV_WIDTH - 1, D_CONV), 1.0)
    state_ssm_re = nrm(ks[3], (N_SSM_LAYERS, DEC_BATCH, SSM_GROUPS, SSM_STATE), 0.3)
    state_ssm_im = nrm(ks[4], (N_SSM_LAYERS, DEC_BATCH, SSM_GROUPS, SSM_STATE), 0.3)
    meta_tokens = nrm(ks[5], (N_META, D_MODEL), 1.0)
    norm_mixer = 1.0 + nrm(ks[6], (DEPTH, D_MODEL), 0.02)
    norm_mlp = 1.0 + nrm(ks[7], (DEPTH, D_MODEL), 0.02)
    norm_final = 1.0 + nrm(ks[8], (D_MODEL,), 0.02)
    conv_w_in = nrm(ks[9], (N_CONV_LAYERS, D_MODEL, 3 * D_CONV), D_MODEL ** -0.5)
    conv_w = nrm(ks[10], (N_CONV_LAYERS, CONV_WIDTH, D_CONV), CONV_WIDTH ** -0.5)
    conv_w_out = nrm(ks[11], (N_CONV_LAYERS, D_CONV, D_MODEL), D_CONV ** -0.5)
    n_idx = jnp.arange(SSM_STATE, dtype=f32)
    ssm_lambda_re = -0.5 + nrm(ks[12], (N_SSM_LAYERS, SSM_GROUPS, SSM_STATE), 0.01)
    ssm_lambda_im = math.pi * n_idx + nrm(ks[13], (N_SSM_LAYERS, SSM_GROUPS, SSM_STATE), 0.01)
    ssm_log_step = jax.random.uniform(ks[14], (N_SSM_LAYERS, SSM_GROUPS), f32,
                                      minval=math.log(1e-3), maxval=math.log(1e-1))
    bsc = (2.0 * SSM_GROUP_WIDTH) ** -0.5
    ssm_b_re = nrm(ks[15], (N_SSM_LAYERS, SSM_GROUPS, SSM_STATE, SSM_GROUP_WIDTH), bsc)
    ssm_b_im = nrm(ks[16], (N_SSM_LAYERS, SSM_GROUPS, SSM_STATE, SSM_GROUP_WIDTH), bsc)
    csc = 0.5
    ssm_c_re = nrm(ks[17], (N_SSM_LAYERS, SSM_GROUPS, SSM_GROUP_WIDTH, SSM_STATE), csc)
    ssm_c_im = nrm(ks[18], (N_SSM_LAYERS, SSM_GROUPS, SSM_GROUP_WIDTH, SSM_STATE), csc)
    ssm_d = nrm(ks[19], (N_SSM_LAYERS, D_MODEL), 1.0)
    ssm_glu_w_a = nrm(ks[20], (N_SSM_LAYERS, D_MODEL, D_MODEL), D_MODEL ** -0.5)
    ssm_glu_w_b = nrm(ks[21], (N_SSM_LAYERS, D_MODEL, D_MODEL), D_MODEL ** -0.5)
    mlp_w_up = nrm(ks[22], (DEPTH, D_MODEL, D_FF), D_MODEL ** -0.5)
    mlp_w_down = nrm(ks[23], (DEPTH, D_FF, D_MODEL), D_FF ** -0.5)
    return {
        "x_prompt": x_prompt, "x_sample": x_sample,
        "state_conv": state_conv, "state_ssm_re": state_ssm_re, "state_ssm_im": state_ssm_im,
        "meta_tokens": meta_tokens,
        "norm_mixer": norm_mixer, "norm_mlp": norm_mlp, "norm_final": norm_final,
        "conv_w_in": conv_w_in, "conv_w": conv_w, "conv_w_out": conv_w_out,
        "ssm_lambda_re": ssm_lambda_re, "ssm_lambda_im": ssm_lambda_im, "ssm_log_step": ssm_log_step,
        "ssm_b_re": ssm_b_re, "ssm_b_im": ssm_b_im, "ssm_c_re": ssm_c_re, "ssm_c_im": ssm_c_im,
        "ssm_d": ssm_d, "ssm_glu_w_a": ssm_glu_w_a, "ssm_glu_w_b": ssm_glu_w_b,
        "mlp_w_up": mlp_w_up, "mlp_w_down": mlp_w_down,
    }


def reference(x_prompt, x_sample, state_conv, state_ssm_re, state_ssm_im, meta_tokens,
              norm_mixer, norm_mlp, norm_final, conv_w_in, conv_w, conv_w_out,
              ssm_lambda_re, ssm_lambda_im, ssm_log_step, ssm_b_re, ssm_b_im,
              ssm_c_re, ssm_c_im, ssm_d, ssm_glu_w_a, ssm_glu_w_b, mlp_w_up, mlp_w_down):
    bp = x_prompt.shape[0]
    meta = jnp.broadcast_to(meta_tokens.astype(x_prompt.dtype)[None], (bp, N_META, D_MODEL))
    hp = jnp.concatenate([meta, x_prompt], axis=1)
    conv0 = jnp.zeros((N_CONV_LAYERS, bp, CONV_WIDTH - 1, D_CONV), state_conv.dtype)
    ssm0_re = jnp.zeros((N_SSM_LAYERS, bp, SSM_GROUPS, SSM_STATE), state_ssm_re.dtype)
    ssm0_im = jnp.zeros((N_SSM_LAYERS, bp, SSM_GROUPS, SSM_STATE), state_ssm_im.dtype)
    yp, conv_p, re_p, im_p = trunk(hp, conv0, ssm0_re, ssm0_im, norm_mixer, norm_mlp, norm_final,
                                   conv_w_in, conv_w, conv_w_out,
                                   ssm_lambda_re, ssm_lambda_im, ssm_log_step, ssm_b_re, ssm_b_im,
                                   ssm_c_re, ssm_c_im, ssm_d, ssm_glu_w_a, ssm_glu_w_b,
                                   mlp_w_up, mlp_w_down)
    y_prompt = yp[:, N_META:]
    y_sample, conv_s, re_s, im_s = trunk(x_sample, state_conv, state_ssm_re, state_ssm_im,
                                         norm_mixer, norm_mlp, norm_final,
                                         conv_w_in, conv_w, conv_w_out,
                                         ssm_lambda_re, ssm_lambda_im, ssm_log_step, ssm_b_re, ssm_b_im,
                                         ssm_c_re, ssm_c_im, ssm_d, ssm_glu_w_a, ssm_glu_w_b,
                                         mlp_w_up, mlp_w_down)
    return (y_prompt, y_sample, conv_p, re_p, im_p, conv_s, re_s, im_s)
```

```cpp
#include <hip/hip_runtime.h>
#include <hip/hip_cooperative_groups.h>
#include <cstdio>
namespace cg = cooperative_groups;

#ifndef PHMASK
#define PHMASK 2047
#endif
#ifndef DBG_LAUNCH_MASK
#define DBG_LAUNCH_MASK 0x1FFF
#endif
#ifndef DBL_PHASE
#define DBL_PHASE -1
#define DBL_REPS 0
#endif
#ifndef N_LAUNCH_MODE
#define N_LAUNCH_MODE 1
#endif

#define LAS __attribute__((address_space(3)))
typedef unsigned short bf16_t;
typedef short bf16x8 __attribute__((ext_vector_type(8)));
typedef float f32x4 __attribute__((ext_vector_type(4)));
typedef float f32x2 __attribute__((ext_vector_type(2)));
typedef float f32x16 __attribute__((ext_vector_type(16)));
typedef unsigned u32x4 __attribute__((ext_vector_type(4)));
typedef unsigned u32x2 __attribute__((ext_vector_type(2)));

constexpr int D = 2048, FF = 8192, LP = 2064, NB = 4, MPROMPT = NB * LP  , NSEQ = 128, MV = MPROMPT + NSEQ * 4  , MP = 8960;
constexpr int NG = 128, NST = 64;
constexpr float EPS = 1e-6f;
constexpr int NTHREADS = 512, NPHASES = 13;
constexpr int RS_UNITS = 8;
constexpr int SPLIT_G2 = 4, SPLIT_DN = 8;

constexpr size_t O_WIN = 0;
constexpr size_t O_WOUT = O_WIN + (size_t)6144 * 2048 * 2;
constexpr size_t O_WUP0 = O_WOUT + (size_t)2048 * 2048 * 2;
constexpr size_t O_WDN0 = O_WUP0 + (size_t)8192 * 2048 * 2;
constexpr size_t O_WGLU = O_WDN0 + (size_t)8192 * 2048 * 2;
constexpr size_t O_WUP1 = O_WGLU + (size_t)4096 * 2048 * 2;
constexpr size_t O_WDN1 = O_WUP1 + (size_t)8192 * 2048 * 2;
constexpr size_t O_H = O_WDN1 + (size_t)8192 * 2048 * 2;
constexpr size_t O_ABF = O_H + (size_t)MP * D * 4;
constexpr size_t O_ACT = O_ABF + (size_t)MP * D * 2;
constexpr size_t O_PART = O_ACT + (size_t)MP * FF * 2;
constexpr size_t O_ABAR = O_PART + (size_t)MP * 64 * 4;
constexpr size_t O_BFR = O_ABAR + (size_t)NG * NST * 8;
constexpr size_t O_CFR = O_BFR + (size_t)NG * 4 * 64 * 16;
constexpr size_t O_BAR = O_CFR + (size_t)NG * 4 * 64 * 16;
constexpr size_t O_END = O_BAR + 16384;
constexpr size_t O_BG = O_ACT;
constexpr size_t O_V = O_ACT + (size_t)MP * D * 2;
constexpr size_t O_ABF2 = O_WUP0;

constexpr size_t OUT_YP = 0, OUT_YS = 16777216, OUT_CONVP = 17825792, OUT_REP = 17842176, OUT_IMP = 17874944, OUT_CONVS = 17907712, OUT_RES = 18432000, OUT_IMS = 19480576;

struct Params { const float* in[24]; float* out; unsigned char* ws; int ph_lo, ph_hi; };
#if defined(__HIP_DEVICE_COMPILE__)
typedef const __attribute__((address_space(4))) Params* KP;
#else
typedef const Params* KP;
#endif
__device__ __forceinline__ KP launder(KP p) { asm volatile("" : "+s"(p)); return p; }
__device__ __forceinline__ int opaque_v(int v) { asm volatile("" : "+v"(v)); return v; }
__device__ __forceinline__ int opaque_s(int v) { asm volatile("" : "+s"(v)); return v; }

typedef __bf16 bf16x2_t __attribute__((ext_vector_type(2)));
__device__ __forceinline__ unsigned pk2(float lo, float hi) { f32x2 v = {lo, hi}; bf16x2_t b = __builtin_convertvector(v, bf16x2_t); return __builtin_bit_cast(unsigned, b); }
__device__ __forceinline__ float bf_lo(unsigned w) { return __uint_as_float(w << 16); }
__device__ __forceinline__ float bf_hi(unsigned w) { return __uint_as_float(w & 0xffff0000u); }

namespace pg8 {
constexpr int BM = 256, BK = 64, HALF = 128, HTB = HALF * BK * 2, STAGE_BYTES = 8 * HTB, NXCD = 8, WGM = 8;
__device__ __forceinline__ int lds_byte(int r, int c) { const int st = (r >> 4) * 2 + (c >> 5), rr = r & 15, cc = c & 31, ob = rr * 64 + cc * 2; return st * 1024 + (ob ^ (((ob >> 9) & 1) << 5)); }
__device__ __forceinline__ void stage_rc(int b, int& R, int& C) { const int st = b / 1024, sb = b % 1024, swz = sb ^ (((sb >> 9) & 1) << 5); R = (st >> 1) * 16 + swz / 64; C = (st & 1) * 32 + (swz % 64) / 2; }
__device__ __forceinline__ int perm32(int rho) { const int n = rho >> 4, i = rho & 15; return 8 * (i >> 2) + 4 * n + (i & 3); }
struct Unit { int pm, pn, ks, slot; };
struct Gemm { const bf16_t* A; const bf16_t* Bt; int M, N, K; };
struct StaticOrder {
    int nM, nN, nwg, G, c, S, nfull;
    __device__ void init(int M, int N, int G_, int c_, int S_) { nM = M / BM; nN = N / BM; nwg = nM * nN; G = G_; c = c_; S = S_; nfull = (S_ > 1) ? (nwg / G_) * G_ : nwg; }
    __device__ void map(int wgid, Unit& u) const {
        { const int q = nwg / NXCD, r = nwg % NXCD, xcd = wgid % NXCD, off = wgid / NXCD; wgid = (xcd < r ? xcd * (q + 1) : r * (q + 1) + (xcd - r) * q) + off; }
        const int nig = WGM * nN, gid = wgid / nig, fm = gid * WGM, gsz = (nM - fm) < WGM ? (nM - fm) : WGM;
        u.pm = fm + ((wgid % nig) % gsz); u.pn = (wgid % nig) / gsz;
    }
    __device__ bool next(int i, Unit& u) const {
        const long L = (long)i * G + c;
        if (L < nfull) { map((int)L, u); u.ks = -1; u.slot = i; return true; }
        const long j = L - nfull; if (j >= (long)(nwg - nfull) * S) return false;
        map(nfull + (int)j / S, u); u.ks = (int)j % S; u.slot = (int)j; return true;
    }
};

template <class Epi>
__device__ __forceinline__ void gemm_phase(LAS unsigned char* lds, const Gemm g, const StaticOrder& S, const Epi& E) {
    const int tid = opaque_v(threadIdx.x), wid = __builtin_amdgcn_readfirstlane(tid >> 6), lane = tid & 63, wr = wid >> 2, wc = wid & 3, fr = lane & 15, fq = lane >> 4;
    const int K = g.K, KS = K / S.S;
    unsigned voffA[2], voffB[2];
#pragma unroll
    for (int i = 0; i < 2; ++i) { int R, C; stage_rc(tid * 16 + i * 8192, R, C); const int Rb = (R & ~31) + perm32(R & 31);
        voffA[i] = (unsigned)(R * K + C) * 2u; voffB[i] = (unsigned)(Rb * K + C) * 2u; }
    const size_t kstep = (size_t)(BK * 2);
    const size_t hstep = (size_t)HALF * K * 2;
    const size_t tstep = 2 * hstep;
    const unsigned ldsw = (unsigned)wid * 1024u;
    const int aoff = lds_byte(wr * 64 + fr, fq * 8), boff = lds_byte(wc * 32 + fr, fq * 8);
#define PG8_SA(b, h) (((b) * 2 + (h)) * HTB)
#define PG8_SB(b, h) ((4 + (b) * 2 + (h)) * HTB)
#define PG8_STAGE(bufoff, gbase, voff) do { _Pragma("unroll") for (int _i = 0; _i < 2; ++_i) \
        __builtin_amdgcn_global_load_lds((const unsigned*)((const char*)(gbase) + (voff)[_i]), (LAS unsigned*)(lds + (bufoff) + ldsw + _i * 8192), 16, 0, 0); } while (0)
#define PG8_LDA(dst, b, h) do { _Pragma("unroll") for (int m = 0; m < 4; ++m) _Pragma("unroll") for (int k = 0; k < 2; ++k) dst[m][k] = *(const LAS bf16x8*)(lds + PG8_SA(b, h) + aoff + m * 2048 + k * 1024); } while (0)
#define PG8_LDB(dst, b, h) do { _Pragma("unroll") for (int n = 0; n < 2; ++n) _Pragma("unroll") for (int k = 0; k < 2; ++k) dst[n][k] = *(const LAS bf16x8*)(lds + PG8_SB(b, h) + boff + n * 2048 + k * 1024); } while (0)
#define PG8_MMA(ai, bj, At, Bt) do { __builtin_amdgcn_s_setprio(1); _Pragma("unroll") for (int m = 0; m < 4; ++m) _Pragma("unroll") for (int n = 0; n < 2; ++n) _Pragma("unroll") for (int k = 0; k < 2; ++k) \
        acc[ai][bj][m][n] = __builtin_amdgcn_mfma_f32_16x16x32_bf16(Bt[n][k], At[m][k], acc[ai][bj][m][n], 0, 0, 0); __builtin_amdgcn_s_setprio(0); } while (0)
#define PG8_WAIT_V(n) asm volatile("s_waitcnt vmcnt(" #n ")" ::: "memory")
#define PG8_WAIT_L(n) asm volatile("s_waitcnt lgkmcnt(" #n ")" ::: "memory")
#define PG8_BAR __builtin_amdgcn_s_barrier()
#define PG8_SCHED __builtin_amdgcn_sched_barrier(0)
    Unit cur, nxt; int ui = 0;
    if (!S.next(0, cur)) return;
    f32x4 acc[2][2][4][2];
#pragma unroll
    for (int a = 0; a < 2; ++a)
#pragma unroll
        for (int b = 0; b < 2; ++b)
#pragma unroll
            for (int m = 0; m < 4; ++m)
#pragma unroll
                for (int n = 0; n < 2; ++n) acc[a][b][m][n] = (f32x4){0.f, 0.f, 0.f, 0.f};
    bf16x8 At[4][2], B0[2][2], B1[2][2];
    size_t koff = cur.ks < 0 ? 0 : (size_t)cur.ks * KS * 2; int nt = (cur.ks < 0 ? K : KS) / BK;
    const char* cA = (const char*)g.A + (size_t)cur.pm * tstep + koff; const char* cB = (const char*)g.Bt + (size_t)cur.pn * tstep + koff;
    PG8_STAGE(PG8_SB(0, 0), cB, voffB); PG8_STAGE(PG8_SA(0, 0), cA, voffA); PG8_STAGE(PG8_SB(0, 1), cB + hstep, voffB); PG8_STAGE(PG8_SA(0, 1), cA + hstep, voffA);
    if (wr == 1) PG8_BAR;
    PG8_WAIT_V(4); PG8_BAR;
    PG8_STAGE(PG8_SB(1, 0), cB + kstep, voffB); PG8_STAGE(PG8_SA(1, 0), cA + kstep, voffA); PG8_STAGE(PG8_SB(1, 1), cB + hstep + kstep, voffB);
    PG8_WAIT_V(6); PG8_BAR;
    for (;;) {
        const bool has_next = S.next(ui + 1, nxt);
        const size_t nkoff = (has_next && nxt.ks >= 0) ? (size_t)nxt.ks * KS * 2 : 0;
        const char* nA = has_next ? (const char*)g.A + (size_t)nxt.pm * tstep + nkoff : cA; const char* nB = has_next ? (const char*)g.Bt + (size_t)nxt.pn * tstep + nkoff : cB;
        for (int t = 0; t < nt; t += 2) {
            const bool last = (t == nt - 2);
            const char* a1 = cA + (size_t)(t + 1) * kstep;
            const char* a2 = last ? nA : cA + (size_t)(t + 2) * kstep; const char* b2 = last ? nB : cB + (size_t)(t + 2) * kstep;
            const char* a3 = a2 + kstep; const char* b3 = b2 + kstep;
            PG8_LDB(B0, 0, 0); PG8_SCHED; PG8_LDA(At, 0, 0); PG8_STAGE(PG8_SA(1, 1), a1 + hstep, voffA);
            PG8_WAIT_L(8); PG8_BAR; PG8_WAIT_L(0); PG8_MMA(0, 0, At, B0); PG8_BAR; PG8_SCHED;
            PG8_LDB(B1, 0, 1); PG8_STAGE(PG8_SB(0, 0), b2, voffB);
            PG8_BAR; PG8_WAIT_L(0); PG8_MMA(0, 1, At, B1); PG8_BAR;
            PG8_LDA(At, 0, 1); PG8_STAGE(PG8_SA(0, 0), a2, voffA);
            PG8_BAR; PG8_WAIT_L(0); PG8_MMA(1, 0, At, B0); PG8_BAR; PG8_SCHED;
            PG8_STAGE(PG8_SB(0, 1), b2 + hstep, voffB);
            PG8_WAIT_V(6); PG8_BAR; PG8_MMA(1, 1, At, B1); PG8_BAR;
            PG8_LDB(B0, 1, 0); PG8_SCHED; PG8_LDA(At, 1, 0); PG8_STAGE(PG8_SA(0, 1), a2 + hstep, voffA);
            PG8_WAIT_L(8); PG8_BAR; PG8_WAIT_L(0); PG8_MMA(0, 0, At, B0); PG8_BAR; PG8_SCHED;
            PG8_LDB(B1, 1, 1); PG8_STAGE(PG8_SB(1, 0), b3, voffB);
            PG8_BAR; PG8_WAIT_L(0); PG8_MMA(0, 1, At, B1); PG8_BAR;
            PG8_LDA(At, 1, 1); PG8_STAGE(PG8_SA(1, 0), a3, voffA);
            PG8_BAR; PG8_WAIT_L(0); PG8_MMA(1, 0, At, B0); PG8_BAR; PG8_SCHED;
            PG8_STAGE(PG8_SB(1, 1), b3 + hstep, voffB);
            PG8_WAIT_V(6); PG8_BAR; PG8_MMA(1, 1, At, B1); PG8_BAR;
        }
        E(acc, cur, wr, wc, fr, fq);
        if (!has_next) break;
#pragma unroll
        for (int a = 0; a < 2; ++a)
#pragma unroll
            for (int b = 0; b < 2; ++b)
#pragma unroll
                for (int m = 0; m < 4; ++m)
#pragma unroll
                    for (int n = 0; n < 2; ++n) acc[a][b][m][n] = (f32x4){0.f, 0.f, 0.f, 0.f};
        cur = nxt; cA = nA; cB = nB; ++ui; nt = (cur.ks < 0 ? K : KS) / BK;
    }
    PG8_WAIT_V(0);
    if (wr == 0) PG8_BAR;
    PG8_BAR;
#undef PG8_SA
#undef PG8_SB
#undef PG8_STAGE
#undef PG8_LDA
#undef PG8_LDB
#undef PG8_MMA
#undef PG8_WAIT_V
#undef PG8_WAIT_L
#undef PG8_BAR
#undef PG8_SCHED
}
}

__device__ __forceinline__ u32x4 pack8(const f32x4 a, const f32x4 b) { u32x4 w; w.x = pk2(a[0], a[1]); w.y = pk2(a[2], a[3]); w.z = pk2(b[0], b[1]); w.w = pk2(b[2], b[3]); return w; }

struct EpiG1 {
    bf16_t* V; bf16_t* BG;
    __device__ __forceinline__ void operator()(const f32x4 (&acc)[2][2][4][2], const pg8::Unit& u, int wr, int wc, int fr, int fq) const {
        const int row0 = u.pm * 256 + wr * 64 + fr;
        if (u.pn < 16) {
            const int ch0 = 128 * u.pn + 32 * wc + 8 * fq;
#pragma unroll
            for (int ai = 0; ai < 2; ++ai)
#pragma unroll
                for (int m = 0; m < 4; ++m) { const size_t r = row0 + ai * 128 + m * 16;
                    *(u32x4*)(V + r * D + ch0) = pack8(acc[ai][0][m][0] * acc[ai][1][m][0], acc[ai][0][m][1] * acc[ai][1][m][1]); }
        } else {
            const int c0 = 256 * (u.pn - 16) + 32 * wc + 8 * fq;
#pragma unroll
            for (int ai = 0; ai < 2; ++ai)
#pragma unroll
                for (int m = 0; m < 4; ++m) { const size_t r = row0 + ai * 128 + m * 16;
#pragma unroll
                    for (int bj = 0; bj < 2; ++bj) *(u32x4*)(BG + r * D + c0 + 128 * bj) = pack8(acc[ai][bj][m][0], acc[ai][bj][m][1]); }
        }
    }
};
__device__ __forceinline__ const float* xsrc(KP kp, int row) {
    if (row < MPROMPT) { const int b = row / LP, pos = row - b * LP; return pos < 16 ? kp->in[5] + (size_t)pos * D : kp->in[0] + ((size_t)b * 2048 + (pos - 16)) * D; }
    if (row < MV) return kp->in[1] + (size_t)(row - MPROMPT) * D;
    return kp->in[5];
}
template <bool WBF> struct EpiRes {
    float* H; float* part; bf16_t* O; KP kp;
    __device__ __forceinline__ void operator()(const f32x4 (&acc)[2][2][4][2], const pg8::Unit& u, int wr, int wc, int fr, int fq) const {
        const int row0 = u.pm * 256 + wr * 64 + fr, c0 = 256 * u.pn + 32 * wc + 8 * fq;
#pragma unroll
        for (int ai = 0; ai < 2; ++ai) {
            f32x4 rv[4][2][2];
#pragma unroll
            for (int m = 0; m < 4; ++m) { const size_t r = row0 + ai * 128 + m * 16;
                const float* rp = WBF ? xsrc(kp, (int)r) + c0 : H + r * D + c0;
#pragma unroll
                for (int bj = 0; bj < 2; ++bj) { rv[m][bj][0] = *(const f32x4*)(rp + 128 * bj); rv[m][bj][1] = *(const f32x4*)(rp + 128 * bj + 4); } }
#pragma unroll
            for (int m = 0; m < 4; ++m) { const size_t r = row0 + ai * 128 + m * 16;
#pragma unroll
                for (int bj = 0; bj < 2; ++bj) { float* hp = H + r * D + c0 + 128 * bj;
                    const f32x4 h0 = rv[m][bj][0] + acc[ai][bj][m][0], h1 = rv[m][bj][1] + acc[ai][bj][m][1];
                    *(f32x4*)hp = h0; *(f32x4*)(hp + 4) = h1;
                    float ss = (h0[0] * h0[0] + h0[1] * h0[1]) + (h0[2] * h0[2] + h0[3] * h0[3]) + (h1[0] * h1[0] + h1[1] * h1[1]) + (h1[2] * h1[2] + h1[3] * h1[3]);
                    ss += __shfl_xor(ss, 16); ss += __shfl_xor(ss, 32);
                    if (fq == 0) part[r * 64 + 8 * u.pn + 4 * bj + wc] = ss;
                    if (WBF) *(u32x4*)(O + r * D + c0 + 128 * bj) = pack8(h0, h1); } }
            asm volatile("" ::: "memory"); }
    }
};
struct EpiUp {
    const LAS float* rstab; bf16_t* O;
    __device__ __forceinline__ void operator()(const f32x4 (&acc)[2][2][4][2], const pg8::Unit& u, int wr, int wc, int fr, int fq) const {
        const int row0 = u.pm * 256 + wr * 64 + fr, c0 = 256 * u.pn + 32 * wc + 8 * fq;
        const LAS float* rt = rstab + u.slot * 256 + wr * 64 + fr;
#pragma unroll
        for (int ai = 0; ai < 2; ++ai) {
#pragma unroll
            for (int m = 0; m < 4; ++m) { const size_t r = row0 + ai * 128 + m * 16; const float rs = rt[ai * 128 + m * 16];
#pragma unroll
                for (int bj = 0; bj < 2; ++bj) { f32x4 a0 = acc[ai][bj][m][0] * rs, a1 = acc[ai][bj][m][1] * rs;
#pragma unroll
                    for (int e = 0; e < 4; ++e) { a0[e] = fmaxf(a0[e], 0.f); a0[e] *= a0[e]; a1[e] = fmaxf(a1[e], 0.f); a1[e] *= a1[e]; }
                    *(u32x4*)(O + r * FF + c0 + 128 * bj) = pack8(a0, a1); } } }
    }
};
struct EpiGlu {
    float* H; float* part; bf16_t* O;
    __device__ __forceinline__ void operator()(const f32x4 (&acc)[2][2][4][2], const pg8::Unit& u, int wr, int wc, int fr, int fq) const {
        const int row0 = u.pm * 256 + wr * 64 + fr, ch0 = 128 * u.pn + 32 * wc + 8 * fq;
#pragma unroll
        for (int ai = 0; ai < 2; ++ai) {
            f32x4 rv[4][2];
#pragma unroll
            for (int m = 0; m < 4; ++m) { const float* hp = H + (size_t)(row0 + ai * 128 + m * 16) * D + ch0; rv[m][0] = *(const f32x4*)hp; rv[m][1] = *(const f32x4*)(hp + 4); }
#pragma unroll
            for (int m = 0; m < 4; ++m) { const size_t r = row0 + ai * 128 + m * 16;
                float* hp = H + r * D + ch0;
                f32x4 h0 = rv[m][0], h1 = rv[m][1];
#pragma unroll
                for (int e = 0; e < 4; ++e) { h0[e] += acc[ai][0][m][0][e] * __builtin_amdgcn_rcpf(1.0f + __expf(-acc[ai][1][m][0][e])); h1[e] += acc[ai][0][m][1][e] * __builtin_amdgcn_rcpf(1.0f + __expf(-acc[ai][1][m][1][e])); }
                *(f32x4*)hp = h0; *(f32x4*)(hp + 4) = h1;
                float ss = (h0[0] * h0[0] + h0[1] * h0[1]) + (h0[2] * h0[2] + h0[3] * h0[3]) + (h1[0] * h1[0] + h1[1] * h1[1]) + (h1[2] * h1[2] + h1[3] * h1[3]);
                ss += __shfl_xor(ss, 16); ss += __shfl_xor(ss, 32);
                if (fq == 0) part[r * 64 + 4 * u.pn + wc] = ss;
                *(u32x4*)(O + r * D + ch0) = pack8(h0, h1); }
            asm volatile("" ::: "memory"); }
    }
};

__device__ __forceinline__ void job_info(KP P_, int j, const float*& src, int& Nsrc, const float*& gain, bf16_t*& dst, int& K, int& k0, int& n0) {
    int mode, ndt; const float* src2 = nullptr; unsigned char* ws = P_->ws;
    if (j < 6144) { src = P_->in[9]; Nsrc = 6144; gain = P_->in[6]; dst = (bf16_t*)(ws + O_WIN); K = 2048; ndt = 96; mode = 1; }
    else if (j < 8192) { j -= 6144; src = P_->in[11]; Nsrc = 2048; gain = nullptr; dst = (bf16_t*)(ws + O_WOUT); K = 2048; ndt = 32; mode = 0; }
    else if (j < 16384) { j -= 8192; src = P_->in[22]; Nsrc = 8192; gain = P_->in[7]; dst = (bf16_t*)(ws + O_WUP0); K = 2048; ndt = 128; mode = 0; }
    else if (j < 24576) { j -= 16384; src = P_->in[23]; Nsrc = 2048; gain = nullptr; dst = (bf16_t*)(ws + O_WDN0); K = 8192; ndt = 32; mode = 0; }
    else if (j < 28672) { j -= 24576; src = P_->in[20]; src2 = P_->in[21]; Nsrc = 2048; gain = nullptr; dst = (bf16_t*)(ws + O_WGLU); K = 2048; ndt = 64; mode = 2; }
    else if (j < 36864) { j -= 28672; src = P_->in[22] + (size_t)2048 * 8192; Nsrc = 8192; gain = P_->in[7] + 2048; dst = (bf16_t*)(ws + O_WUP1); K = 2048; ndt = 128; mode = 0; }
    else { j -= 36864; src = P_->in[23] + (size_t)8192 * 2048; Nsrc = 2048; gain = nullptr; dst = (bf16_t*)(ws + O_WDN1); K = 8192; ndt = 32; mode = 0; }
    const int nb = j % ndt, kc = j / ndt; k0 = kc * 32; n0 = nb * 64;
    int col = n0;
    if (mode == 1) { if (n0 < 4096) { const int pn = n0 >> 8, bj = (n0 >> 7) & 1, j0 = n0 & 127; col = (bj ? 4096 : 2048) + 128 * pn + j0; } else col = n0 - 4096; }
    if (mode == 2) { const int pn = n0 >> 8, bj = (n0 >> 7) & 1, j0 = n0 & 127; col = 128 * pn + j0; if (bj) src = src2; }
    src += col;
}
constexpr int NJOBS = 45056, NJOBS_L0 = 24576, NJOBS_F1 = 31744, NJOBS_F2 = 38912;
__device__ __forceinline__ void convert_jobs(KP kp, int j0, int j1, int widx, int nw, int lane) {
    for (int j = j0 + widx; j < j1; j += nw) {
        const float* src; int Nsrc; const float* gain; bf16_t* dst; int K, k0, n0;
        job_info(kp, j, src, Nsrc, gain, dst, K, k0, n0);
        const float* sp = src + (size_t)k0 * Nsrc + lane;
        float v[32];
#pragma unroll
        for (int i = 0; i < 32; ++i) v[i] = sp[(size_t)i * Nsrc];
        if (gain) {
#pragma unroll
            for (int i = 0; i < 32; ++i) v[i] *= gain[k0 + i]; }
        bf16_t* dp = dst + (size_t)(n0 + lane) * K + k0;
#pragma unroll
        for (int o = 0; o < 4; ++o) { u32x4 w; w.x = pk2(v[8 * o], v[8 * o + 1]); w.y = pk2(v[8 * o + 2], v[8 * o + 3]); w.z = pk2(v[8 * o + 4], v[8 * o + 5]); w.w = pk2(v[8 * o + 6], v[8 * o + 7]);
            *(u32x4*)(dp + 8 * o) = w; }
    }
}
__device__ __forceinline__ void filler_phase(KP kp, int bid, int G, int r, int j0, int j1) {
    kp = launder(kp); bid = opaque_s(bid); G = opaque_s(G);
    const int tid = opaque_v(threadIdx.x), lane = tid & 63, wv = __builtin_amdgcn_readfirstlane(tid >> 6);
    convert_jobs(kp, j0, j1, (bid - r) * 8 + wv, (G - r) * 8, lane);
}
__device__ __forceinline__ void prep_phase(KP kp, LAS unsigned char* lds, int bid, int G) {
    kp = launder(kp); bid = opaque_s(bid); G = opaque_s(G);
    const int tid = opaque_v(threadIdx.x), lane = tid & 63, wave = tid >> 6;
    convert_jobs(kp, 0, 8192, bid * 8 + __builtin_amdgcn_readfirstlane(wave), 8 * G, lane);
    convert_jobs(kp, 24576, 28672, bid * 8 + __builtin_amdgcn_readfirstlane(wave), 8 * G, lane);
    if (false) {
        const int wv = __builtin_amdgcn_readfirstlane(wave);
        for (int j = bid * 8 + wv; j < NJOBS; j += 8 * G) {
            const float* src; int Nsrc; const float* gain; bf16_t* dst; int K, k0, n0;
            job_info(kp, j, src, Nsrc, gain, dst, K, k0, n0);
            const float* sp = src + (size_t)k0 * Nsrc + lane;
            float v[32];
#pragma unroll
            for (int i = 0; i < 32; ++i) v[i] = sp[(size_t)i * Nsrc];
            if (gain) {
#pragma unroll
                for (int i = 0; i < 32; ++i) v[i] *= gain[k0 + i]; }
            bf16_t* dp = dst + (size_t)(n0 + lane) * K + k0;
#pragma unroll
            for (int o = 0; o < 4; ++o) { u32x4 w; w.x = pk2(v[8 * o], v[8 * o + 1]); w.y = pk2(v[8 * o + 2], v[8 * o + 3]); w.z = pk2(v[8 * o + 4], v[8 * o + 5]); w.w = pk2(v[8 * o + 6], v[8 * o + 7]);
                *(u32x4*)(dp + 8 * o) = w; }
        }
    }
    {   const Params P = *launder(kp);
        float* H = (float*)(P.ws + O_H); bf16_t* A = (bf16_t*)(P.ws + O_ABF);
        for (int row = wave * G + bid; row < MP; row += 8 * G) {
            const float* xs = nullptr;
            if (row < MPROMPT) { const int b = row / LP, pos = row % LP; xs = pos < 16 ? P.in[5] + (size_t)pos * D : P.in[0] + ((size_t)b * 2048 + (pos - 16)) * D; }
            else if (row < MV) xs = P.in[1] + (size_t)(row - MPROMPT) * D;
            f32x4 v[8]; float ss = 0.f;
#pragma unroll
            for (int j = 0; j < 8; ++j) { v[j] = xs ? *(const f32x4*)(xs + 4 * lane + 256 * j) : (f32x4){0.f, 0.f, 0.f, 0.f}; ss += (v[j][0] * v[j][0] + v[j][1] * v[j][1]) + (v[j][2] * v[j][2] + v[j][3] * v[j][3]); }
#pragma unroll
            for (int o = 1; o < 64; o <<= 1) ss += __shfl_xor(ss, o);
            const float rs = rsqrtf(ss * (1.0f / D) + EPS);
#pragma unroll
            for (int j = 0; j < 8; ++j) {
                u32x2 w; w.x = pk2(v[j][0] * rs, v[j][1] * rs); w.y = pk2(v[j][2] * rs, v[j][3] * rs); *(u32x2*)(A + (size_t)row * D + 4 * lane + 256 * j) = w; }
        }
    }
    {   const Params P = *launder(kp);
        const int gt = bid * NTHREADS + tid, NT = G * NTHREADS;
        for (int i = gt; i < NG * NST; i += NT) { const int g = i >> 6, p = i & 63;
            const float dt = expf(P.in[14][g]), lr = P.in[12][i], li = P.in[13][i];
            const float mag = expf(lr * dt), are = mag * cosf(li * dt), aim = mag * sinf(li * dt);
            ((f32x2*)(P.ws + O_ABAR))[i] = (f32x2){are, aim};
            const float nr = are - 1.0f, ni = aim, den = lr * lr + li * li, qre = (nr * lr + ni * li) / den, qim = (ni * lr - nr * li) / den;
            const float* bre = P.in[15] + (size_t)i * 16; const float* bim = P.in[16] + (size_t)i * 16;
            bf16_t* BF = (bf16_t*)(P.ws + O_BFR);
#pragma unroll
            for (int ch = 0; ch < 2; ++ch) { f32x4 r0 = *(const f32x4*)(bre + 8 * ch), r1 = *(const f32x4*)(bre + 8 * ch + 4), i0 = *(const f32x4*)(bim + 8 * ch), i1 = *(const f32x4*)(bim + 8 * ch + 4);
                const f32x4 o0 = r0 * qre - i0 * qim, o1 = r1 * qre - i1 * qim, m0 = i0 * qre + r0 * qim, m1 = i1 * qre + r1 * qim;
                const int ln = (p & 31) + 32 * ch, blk = p >> 5;
                *(u32x4*)(BF + ((size_t)(g * 4 + blk) * 64 + ln) * 8) = pack8(o0, o1);
                *(u32x4*)(BF + ((size_t)(g * 4 + 2 + blk) * 64 + ln) * 8) = pack8(m0, m1); }
        }
        for (int i = gt; i < NG * 4 * 64; i += NT) { const int g = i >> 8, kk = (i >> 6) & 3, l = i & 63, c = l & 15, p0 = 16 * kk + 4 * (l >> 4);
            const f32x4 cr = *(const f32x4*)(P.in[17] + ((size_t)g * 16 + c) * 64 + p0), ci = *(const f32x4*)(P.in[18] + ((size_t)g * 16 + c) * 64 + p0);
            u32x4 w; w.x = pk2(cr[0], -ci[0]); w.y = pk2(cr[1], -ci[1]); w.z = pk2(cr[2], -ci[2]); w.w = pk2(cr[3], -ci[3]);
            *(u32x4*)((bf16_t*)(P.ws + O_CFR) + (size_t)i * 8) = w; }
    }
}

__device__ __forceinline__ void unpack8(const u32x4 w, float (&f)[8]) { f[0] = bf_lo(w.x); f[1] = bf_hi(w.x); f[2] = bf_lo(w.y); f[3] = bf_hi(w.y); f[4] = bf_lo(w.z); f[5] = bf_hi(w.z); f[6] = bf_lo(w.w); f[7] = bf_hi(w.w); }
__device__ __forceinline__ void conv_phase(KP kp, int bid, int G) {
    const Params P = *launder(kp); bid = opaque_s(bid); G = opaque_s(G);
    const int tid = opaque_v(threadIdx.x), half = tid >> 8, ch = (tid & 255) * 8;
    bf16_t* BG = (bf16_t*)(P.ws + O_BG); const bf16_t* V = (const bf16_t*)(P.ws + O_V);
    float w0[8], w1[8], w2[8];
#pragma unroll
    for (int e = 0; e < 8; ++e) { w0[e] = P.in[10][ch + e]; w1[e] = P.in[10][D + ch + e]; w2[e] = P.in[10][2 * D + ch + e]; }
    for (int item = half * G + bid; item < MV / 8; item += 2 * G) {
        const int row0 = item * 8; const bool smp = row0 >= MPROMPT;
        const int b = smp ? 0 : row0 / LP, pos0 = smp ? 0 : row0 - b * LP, seq0 = smp ? (row0 - MPROMPT) / 4 : 0;
        u32x4 vq[8], bq[8];
#pragma unroll
        for (int r = 0; r < 8; ++r) { vq[r] = *(const u32x4*)(V + (size_t)(row0 + r) * D + ch); bq[r] = *(const u32x4*)(BG + (size_t)(row0 + r) * D + ch); }
        float vm2[8], vm1[8], sm2[8], sm1[8];
        if (smp) { const float* st = P.in[2] + (size_t)seq0 * 2 * D + ch;
#pragma unroll
            for (int e = 0; e < 8; ++e) { vm2[e] = st[e]; vm1[e] = st[D + e]; sm2[e] = st[2 * D + e]; sm1[e] = st[3 * D + e]; } }
        else if (pos0 == 0) {
#pragma unroll
            for (int e = 0; e < 8; ++e) { vm2[e] = 0.f; vm1[e] = 0.f; sm2[e] = 0.f; sm1[e] = 0.f; } }
        else { unpack8(*(const u32x4*)(V + (size_t)(row0 - 2) * D + ch), vm2); unpack8(*(const u32x4*)(V + (size_t)(row0 - 1) * D + ch), vm1);
#pragma unroll
            for (int e = 0; e < 8; ++e) { sm2[e] = 0.f; sm1[e] = 0.f; } }
#pragma unroll
        for (int r = 0; r < 8; ++r) {
            if (r == 4 && smp) {
                float* o = P.out + OUT_CONVS + (size_t)seq0 * 2 * D + ch;
                *(f32x4*)o = (f32x4){vm2[0], vm2[1], vm2[2], vm2[3]}; *(f32x4*)(o + 4) = (f32x4){vm2[4], vm2[5], vm2[6], vm2[7]};
                *(f32x4*)(o + D) = (f32x4){vm1[0], vm1[1], vm1[2], vm1[3]}; *(f32x4*)(o + D + 4) = (f32x4){vm1[4], vm1[5], vm1[6], vm1[7]};
#pragma unroll
                for (int e = 0; e < 8; ++e) { vm2[e] = sm2[e]; vm1[e] = sm1[e]; } }
            float v[8], bg[8]; unpack8(vq[r], v); unpack8(bq[r], bg);
            f32x4 o0, o1;
#pragma unroll
            for (int e = 0; e < 4; ++e) { o0[e] = bg[e] * (w0[e] * vm2[e] + w1[e] * vm1[e] + w2[e] * v[e]); o1[e] = bg[e + 4] * (w0[e + 4] * vm2[e + 4] + w1[e + 4] * vm1[e + 4] + w2[e + 4] * v[e + 4]); }
            *(u32x4*)(BG + (size_t)(row0 + r) * D + ch) = pack8(o0, o1);
#pragma unroll
            for (int e = 0; e < 8; ++e) { vm2[e] = vm1[e]; vm1[e] = v[e]; } }
        if (smp || pos0 + 8 == LP) { float* o = smp ? P.out + OUT_CONVS + (size_t)(seq0 + 1) * 2 * D + ch : P.out + OUT_CONVP + (size_t)b * 2 * D + ch;
            *(f32x4*)o = (f32x4){vm2[0], vm2[1], vm2[2], vm2[3]}; *(f32x4*)(o + 4) = (f32x4){vm2[4], vm2[5], vm2[6], vm2[7]};
            *(f32x4*)(o + D) = (f32x4){vm1[0], vm1[1], vm1[2], vm1[3]}; *(f32x4*)(o + D + 4) = (f32x4){vm1[4], vm1[5], vm1[6], vm1[7]}; }
    }
}

constexpr int S5_CUT = 44;
constexpr int S5_PITCH = 68, S5_UP = 20, S5_RSQ_BYTES = 2112 * 4, S5_WLDS = 32 * S5_PITCH * 4 + 32 * S5_UP * 4 + 128;
template <int MODE>
__device__ __forceinline__ void s5_job(const Params& P, LAS unsigned char* lds, LAS unsigned char* wl, int lane, int g, int idx, int ck0, int ck1, float& hr, float& hi) {
    constexpr bool SAMPLE = (MODE == 1), LIGHT = (MODE == 2);
    const float* Hb = (const float*)(P.ws + O_H); const float* part = (const float*)(P.ws + O_PART); bf16_t* GA = (bf16_t*)(P.ws + O_ABF);
    const int t32 = lane & 31, hlf = lane >> 5, t16 = lane & 15, q = lane >> 4;
    const f32x2 ab = ((const f32x2*)(P.ws + O_ABAR))[g * 64 + lane]; const float ar = ab[0], ai = ab[1];
    bf16x8 Bf[4], Cf[4];
#pragma unroll
    for (int i = 0; i < 4; ++i) { Bf[i] = ((const bf16x8*)(P.ws + O_BFR))[(g * 4 + i) * 64 + lane]; if (!LIGHT) Cf[i] = ((const bf16x8*)(P.ws + O_CFR))[(g * 4 + i) * 64 + lane]; }
    const float* gn = P.in[6] + D;
    const f32x4 gnA0 = *(const f32x4*)(gn + 16 * g + 8 * hlf), gnA1 = *(const f32x4*)(gn + 16 * g + 8 * hlf + 4);
    const f32x4 z4 = (f32x4){0.f, 0.f, 0.f, 0.f};
    const f32x4 dE = LIGHT ? z4 : *(const f32x4*)(P.in[19] + 16 * g + 4 * q);
    const LAS float* rsq = (const LAS float*)lds;
    LAS unsigned* Hp = (LAS unsigned*)wl; LAS float* U = (LAS float*)(wl + 32 * S5_PITCH * 4);
    float c15r = 0.f, c15i = 0.f;
    const int rowbase = SAMPLE ? MPROMPT + 32 * idx : idx * LP;
    f32x4 x0 = z4, x1 = z4;
    { const size_t row = rowbase + 32 * ck0 + t32; x0 = *(const f32x4*)(Hb + row * D + 16 * g + 8 * hlf); x1 = *(const f32x4*)(Hb + row * D + 16 * g + 8 * hlf + 4); }
    for (int ck = ck0; ck < ck1; ++ck) {
        const int row0 = rowbase + 32 * ck, nvalid = SAMPLE ? 32 : (LP - 32 * ck < 32 ? LP - 32 * ck : 32);
        float rs;
        if (SAMPLE) { const size_t row = row0 + t32; float ss = 0.f; const f32x4* pp = (const f32x4*)(part + row * 64 + 32 * hlf);
#pragma unroll
            for (int i = 0; i < 8; ++i) { const f32x4 v = pp[i]; ss += (v[0] + v[1]) + (v[2] + v[3]); }
            ss += __shfl_xor(ss, 32); rs = rsqrtf(ss * (1.0f / D) + EPS); }
        else rs = rsq[32 * ck + t32];
        f32x4 u0 = x0 * rs * gnA0, u1 = x1 * rs * gnA1;
        if (!SAMPLE && t32 >= nvalid) { u0 = z4; u1 = z4; }
        if (SAMPLE && hlf == 0) U[t32 * S5_UP + 16] = rs;
        union { u32x4 u; bf16x8 b; } af; af.u = pack8(u0, u1);
        if (!SAMPLE && ck + 1 < ck1) {
            const size_t row = row0 + 32 + t32; x0 = *(const f32x4*)(Hb + row * D + 16 * g + 8 * hlf); x1 = *(const f32x4*)(Hb + row * D + 16 * g + 8 * hlf + 4); }
        const f32x16 z16 = {0.f, 0.f, 0.f, 0.f, 0.f, 0.f, 0.f, 0.f, 0.f, 0.f, 0.f, 0.f, 0.f, 0.f, 0.f, 0.f};
        f32x16 R0 = __builtin_amdgcn_mfma_f32_32x32x16_bf16(af.b, Bf[0], z16, 0, 0, 0);
        f32x16 R1 = __builtin_amdgcn_mfma_f32_32x32x16_bf16(af.b, Bf[1], z16, 0, 0, 0);
        f32x16 I0 = __builtin_amdgcn_mfma_f32_32x32x16_bf16(af.b, Bf[2], z16, 0, 0, 0);
        f32x16 I1 = __builtin_amdgcn_mfma_f32_32x32x16_bf16(af.b, Bf[3], z16, 0, 0, 0);
#pragma unroll
        for (int i = 0; i < 16; ++i) {
            auto sr = __builtin_amdgcn_permlane32_swap(__float_as_uint(R0[i]), __float_as_uint(R1[i]), false, false); R0[i] = __uint_as_float(sr[0]); R1[i] = __uint_as_float(sr[1]);
            auto si = __builtin_amdgcn_permlane32_swap(__float_as_uint(I0[i]), __float_as_uint(I1[i]), false, false); I0[i] = __uint_as_float(si[0]); I1[i] = __uint_as_float(si[1]); }
        float h0r[8], h0i[8];
        if (SAMPLE) {
#pragma unroll
            for (int s = 0; s < 8; ++s) { const size_t o = ((size_t)(8 * idx + s) * NG + g) * NST + lane; h0r[s] = P.in[3][o]; h0i[s] = P.in[4][o]; } }
#pragma unroll
        for (int t = 0; t < 32; ++t) {
            const int i = 4 * (t >> 3) + (t & 3); const bool up = (t >> 2) & 1;
            const float bre = up ? R1[i] : R0[i], bim = up ? I1[i] : I0[i];
            if (SAMPLE && (t & 3) == 0) { hr = h0r[t >> 2]; hi = h0i[t >> 2]; }
            const float nr = fmaf(ar, hr, fmaf(-ai, hi, bre)), ni = fmaf(ar, hi, fmaf(ai, hr, bim));
            hr = nr; hi = ni;
            if (!LIGHT) Hp[t * S5_PITCH + lane] = pk2(nr, ni);
            if (MODE == 0 && t == 15) { c15r = nr; c15i = ni; }
            if (SAMPLE && (t & 3) == 3) { const size_t o = ((size_t)(8 * idx + (t >> 2)) * NG + g) * NST + lane; P.out[OUT_RES + o] = nr; P.out[OUT_IMS + o] = ni; }
        }
        if (!LIGHT) {
        asm volatile("s_waitcnt lgkmcnt(0)" ::: "memory");
#pragma unroll
        for (int tb = 0; tb < 2; ++tb) {
            f32x4 y = z4;
#pragma unroll
            for (int kk = 0; kk < 4; ++kk) { const bf16x8 hf = *(const LAS bf16x8*)(Hp + (16 * tb + t16) * S5_PITCH + 16 * kk + 4 * q);
                y = __builtin_amdgcn_mfma_f32_16x16x32_bf16(Cf[kk], hf, y, 0, 0, 0); }
            const int t = 16 * tb + t16;
            if (t < nvalid) { const size_t r2 = row0 + t; const float rs2 = SAMPLE ? U[t * S5_UP + 16] : rsq[32 * ck + t];
                const f32x4 uu = *(const f32x4*)(Hb + r2 * D + 16 * g + 4 * q) * rs2 * *(const f32x4*)(gn + 16 * g + 4 * q);
                f32x4 o;
#pragma unroll
                for (int e = 0; e < 4; ++e) { const float yy = y[e] + dE[e] * uu[e];
                    const float z = 1.5957691216057308f * (yy + 0.044715f * yy * yy * yy); o[e] = yy * __builtin_amdgcn_rcpf(1.0f + __expf(-z)); }
                u32x2 w; w.x = pk2(o[0], o[1]); w.y = pk2(o[2], o[3]);
                *(u32x2*)(GA + r2 * D + 16 * g + 4 * q) = w; }
        }
        asm volatile("s_waitcnt lgkmcnt(0)" ::: "memory");
        }
    }
    if (MODE == 0 && ck1 == 65) { const size_t o = ((size_t)idx * NG + g) * NST + lane; P.out[OUT_REP + o] = c15r; P.out[OUT_IMP + o] = c15i; }
}
__device__ __forceinline__ void s5_phase(KP kp, LAS unsigned char* lds, int bid, int G) {
    const Params P = *launder(kp); bid = opaque_s(bid); G = opaque_s(G);
    const int tid = opaque_v(threadIdx.x), lane = tid & 63, wave = __builtin_amdgcn_readfirstlane(tid >> 6);
    LAS unsigned char* wl = lds + S5_RSQ_BYTES + wave * S5_WLDS;
    const float* part = (const float*)(P.ws + O_PART);
    bool first = true;
    for (int pb = bid; pb < 256 || first; pb += G) {
        const int b = pb >> 6, sg = (pb >> 5) & 1, ck0 = sg ? S5_CUT : 0, ck1 = sg ? 65 : S5_CUT;
        if (pb < 256) {
            LAS float* rsq = (LAS float*)lds; const int rend = 32 * ck1 < LP ? 32 * ck1 : LP;
            for (int r = tid; r < rend; r += NTHREADS) { const f32x4* pp = (const f32x4*)(part + (size_t)(b * LP + r) * 64); float ss = 0.f;
#pragma unroll
                for (int i = 0; i < 16; ++i) { const f32x4 v = pp[i]; ss += (v[0] + v[1]) + (v[2] + v[3]); }
                rsq[r] = rsqrtf(ss * (1.0f / D) + EPS); }
        }
        __syncthreads();
        if (wave < 4) { if (pb < 256) { const int g = 4 * (pb & 31) + wave; float hr = 0.f, hi = 0.f;
            if (ck0 > 0) s5_job<2>(P, lds, wl, lane, g, b, 0, ck0, hr, hi);
            s5_job<0>(P, lds, wl, lane, g, b, ck0, ck1, hr, hi); } }
        if (wave < 4 && first) { for (int sj = bid * 4 + wave; sj < 16 * NG; sj += 4 * G) { float hr = 0.f, hi = 0.f; s5_job<1>(P, lds, wl, lane, sj % NG, sj / NG, 0, 1, hr, hi); } }
        first = false;
        __syncthreads();
    }
}


__device__ __forceinline__ float* slot_ptr(unsigned char* ws, int slot) { return (float*)(ws + (slot < 128 ? O_WIN + (size_t)slot * 262144 : O_ABF + (size_t)(slot - 128) * 262144)); }
__device__ __forceinline__ void final_phase(KP kp, int bid, int G) {
    const Params P = *launder(kp); bid = opaque_s(bid); G = opaque_s(G);
    const int tid = opaque_v(threadIdx.x), lane = tid & 63, wave = __builtin_amdgcn_readfirstlane(tid >> 6);
    const float* H = (const float*)(P.ws + O_H); const float* gf = P.in[8];
    pg8::StaticOrder SO; SO.init(MP, 2048, G, 0, SPLIT_DN);
    const bool split = !(SO.nwg % G == 0 || (long)(SO.nwg % G) * SPLIT_DN > G);
    const int ntail = split ? SO.nwg - SO.nfull : 0;
    for (int row = wave * G + bid; row < MV; row += 8 * G) {
        float* o;
        if (row < MPROMPT) { const int b = row / LP, pos = row % LP; if (pos < 16) continue; o = P.out + OUT_YP + ((size_t)b * 2048 + (pos - 16)) * D; }
        else o = P.out + OUT_YS + (size_t)(row - MPROMPT) * D;
        f32x4 v[8];
#pragma unroll
        for (int j = 0; j < 8; ++j) v[j] = *(const f32x4*)(H + (size_t)row * D + 4 * lane + 256 * j);
        const int pm = row >> 8, rl = row & 255;
        for (int tu = 0; tu < ntail; ++tu) { pg8::Unit u; SO.map(SO.nfull + tu, u);
            if (u.pm == pm) { f32x4 a = (f32x4){0.f, 0.f, 0.f, 0.f};
                for (int s2 = 0; s2 < SPLIT_DN; ++s2) a += *(const f32x4*)(slot_ptr(P.ws, tu * SPLIT_DN + s2) + (size_t)rl * 256 + 4 * lane);
#pragma unroll
                for (int j = 0; j < 8; ++j) if (j == u.pn) v[j] += a; } }
        float ss = 0.f;
#pragma unroll
        for (int j = 0; j < 8; ++j) ss += (v[j][0] * v[j][0] + v[j][1] * v[j][1]) + (v[j][2] * v[j][2] + v[j][3] * v[j][3]);
#pragma unroll
        for (int of = 1; of < 64; of <<= 1) ss += __shfl_xor(ss, of);
        const float rs = rsqrtf(ss * (1.0f / D) + EPS);
#pragma unroll
        for (int j = 0; j < 8; ++j) { const f32x4 gg = *(const f32x4*)(gf + 4 * lane + 256 * j); *(f32x4*)(o + 4 * lane + 256 * j) = v[j] * rs * gg; }
    }
}
struct EpiAll {
    int mode; float* H; float* part; bf16_t* O; bf16_t* O2; unsigned char* ws; KP kp; const LAS float* rstab;
    __device__ __forceinline__ void operator()(const f32x4 (&acc)[2][2][4][2], const pg8::Unit& u, int wr, int wc, int fr, int fq) const {
        if (u.ks >= 0) {
            float* Pp = slot_ptr(ws, u.slot) + (size_t)(wr * 64 + fr) * 256 + 32 * wc + 8 * fq;
#pragma unroll
            for (int ai = 0; ai < 2; ++ai)
#pragma unroll
                for (int m = 0; m < 4; ++m)
#pragma unroll
                    for (int bj = 0; bj < 2; ++bj) { float* p = Pp + (size_t)(ai * 128 + m * 16) * 256 + 128 * bj; *(f32x4*)p = acc[ai][bj][m][0]; *(f32x4*)(p + 4) = acc[ai][bj][m][1]; }
        }
        else if (mode == 0) { EpiG1 e{O, O2}; e(acc, u, wr, wc, fr, fq); }
        else if (mode == 1) { EpiRes<true> e{H, part, O, kp}; e(acc, u, wr, wc, fr, fq); }
        else if (mode == 2) { EpiUp e{rstab, O}; e(acc, u, wr, wc, fr, fq); }
        else if (mode == 3) { EpiRes<false> e{H, part, nullptr, kp}; e(acc, u, wr, wc, fr, fq); }
        else { EpiGlu e{H, part, O}; e(acc, u, wr, wc, fr, fq); }
    }
};
__device__ __forceinline__ void reduce_phase(KP kp, int bid, int G, int S, bool wbf) {
    const Params P = *launder(kp); bid = opaque_s(bid); G = opaque_s(G);
    const int tid = opaque_v(threadIdx.x), lane = tid & 63, wave = tid >> 6;
    float* H = (float*)(P.ws + O_H); float* part = (float*)(P.ws + O_PART); bf16_t* A = (bf16_t*)(P.ws + O_ABF);
    pg8::StaticOrder SO; SO.init(MP, 2048, G, 0, S);
    if (SO.nwg % G == 0 || (long)(SO.nwg % G) * S > G) return;
    const int ntail = SO.nwg - SO.nfull;
    constexpr int RB = 3;
    for (int w0 = wave * G + bid; w0 < ntail * 256; w0 += RB * 8 * G) {
        f32x4 a[RB], res[RB]; int tuv[RB], rv[RB], pmv[RB], pnv[RB];
#pragma unroll
        for (int k = 0; k < RB; ++k) { const int w = w0 + k * 8 * G; const bool ok = w < ntail * 256; const int ww = ok ? w : w0;
            tuv[k] = ww >> 8; rv[k] = ww & 255; pg8::Unit u; SO.map(SO.nfull + tuv[k], u); pmv[k] = u.pm; pnv[k] = ok ? u.pn : -1;
            a[k] = (f32x4){0.f, 0.f, 0.f, 0.f};
            for (int s2 = 0; s2 < S; ++s2) a[k] += *(const f32x4*)(slot_ptr(P.ws, tuv[k] * S + s2) + (size_t)rv[k] * 256 + 4 * lane);
            const size_t off = (size_t)(pmv[k] * 256 + rv[k]) * D + u.pn * 256 + 4 * lane;
            res[k] = wbf ? *(const f32x4*)(xsrc(kp, pmv[k] * 256 + rv[k]) + u.pn * 256 + 4 * lane) : *(const f32x4*)(H + off); }
#pragma unroll
        for (int k = 0; k < RB; ++k) { if (pnv[k] < 0) continue;
            const size_t row = (size_t)(pmv[k] * 256 + rv[k]);
            const f32x4 h = res[k] + a[k]; *(f32x4*)(H + row * D + pnv[k] * 256 + 4 * lane) = h;
            float ss = (h[0] * h[0] + h[1] * h[1]) + (h[2] * h[2] + h[3] * h[3]);
            ss += __shfl_xor(ss, 1); ss += __shfl_xor(ss, 2); ss += __shfl_xor(ss, 4);
            if ((lane & 7) == 0) part[row * 64 + 8 * pnv[k] + (lane >> 3)] = ss;
            if (wbf) { u32x2 o; o.x = pk2(h[0], h[1]); o.y = pk2(h[2], h[3]); *(u32x2*)(A + row * D + pnv[k] * 256 + 4 * lane) = o; } }
    }
}

#define XB_TMO      128
#define XB_XCNT(j)  (256  + 64 * (j))
#define XB_XSUB(j)  (1280 + 64 * (j))
#define XB_XGEN(j)  (2304 + 64 * (j))
#define XB_TOP      3328
#define XB_TOPGEN   3392
#define XCD_BAR_WORDS 3456
#define XB_SPIN_CAP (1u << 18)
__device__ __forceinline__ unsigned xb_ld(unsigned* p)              { return __hip_atomic_load(p, __ATOMIC_RELAXED, __HIP_MEMORY_SCOPE_AGENT); }
__device__ __forceinline__ unsigned xb_add(unsigned* p, unsigned v) { return __hip_atomic_fetch_add(p, v, __ATOMIC_RELAXED, __HIP_MEMORY_SCOPE_AGENT); }
__device__ __forceinline__ unsigned xb_xcc_id() { return (unsigned)__builtin_amdgcn_s_getreg((3 << 11) | 20) & 0xFu; }
#define XB_SPIN(cond, bar) do { unsigned _sp = 0; while (cond) { __builtin_amdgcn_s_sleep(1); \
    if ((++_sp & 255u) == 0u) { if (xb_ld(&(bar)[XB_TMO])) break; if (_sp > XB_SPIN_CAP) { atomicAdd(&(bar)[XB_TMO], 1u); break; } } } } while (0)
__device__ __forceinline__ void xcd_barrier_complete(unsigned* bar, unsigned x, unsigned G, unsigned& nloc, unsigned& nx) {
    unsigned sum, cnt, mine, sp = 0u;
    for (;;) {
        sum = 0u; cnt = 0u; mine = 0u;
#pragma unroll
        for (unsigned j = 0; j < 16; ++j) { const unsigned c = xb_ld(&bar[XB_XCNT(j)]); sum += c; cnt += (c > 0u) ? 1u : 0u; mine = (j == x) ? c : mine; }
        if (sum == G) break;
        __builtin_amdgcn_s_sleep(1);
        if ((++sp & 255u) == 0u) { if (xb_ld(&bar[XB_TMO])) break; if (sp > XB_SPIN_CAP) { atomicAdd(&bar[XB_TMO], 1u); break; } }
    }
    nloc = mine > 0u ? mine : 1u; nx = cnt > 0u ? cnt : 1u;
}
__device__ __forceinline__ void xcd_barrier(unsigned* bar, volatile LAS unsigned* st) {
    asm volatile("s_waitcnt vmcnt(0)" ::: "memory");
    __syncthreads();
    if (threadIdx.x == 0) {
        __builtin_amdgcn_s_waitcnt(0);
        const unsigned x = xb_xcc_id();
        unsigned nloc = st[0], nx = st[1];
        if (nloc == 0u) { xcd_barrier_complete(bar, x, gridDim.x, nloc, nx); st[0] = nloc; st[1] = nx; }
        const unsigned old = xb_add(&bar[XB_XSUB(x)], 1u);
        const unsigned gen = old / nloc;
        if (old + 1u == (gen + 1u) * nloc) {
            __builtin_amdgcn_fence(__ATOMIC_RELEASE, "agent");
            asm volatile("s_waitcnt vmcnt(0)" ::: "memory");
            const unsigned og = xb_add(&bar[XB_TOP], 1u);
            const unsigned tg = og / nx;
            if (og + 1u == (tg + 1u) * nx) xb_add(&bar[XB_TOPGEN], 1u);
            else XB_SPIN(xb_ld(&bar[XB_TOPGEN]) == tg, bar);
            __builtin_amdgcn_fence(__ATOMIC_ACQUIRE, "agent");
            xb_add(&bar[XB_XGEN(x)], 1u);
            asm volatile("s_waitcnt vmcnt(0)" ::: "memory");
        } else {
            XB_SPIN(xb_ld(&bar[XB_XGEN(x)]) == gen, bar);
            __builtin_amdgcn_fence(__ATOMIC_ACQUIRE, "agent");
            asm volatile("s_waitcnt vmcnt(0)" ::: "memory");
        }
    }
    __syncthreads();
}

__global__ void __launch_bounds__(NTHREADS, 2) fwd_kernel(Params Parg) {
    extern __shared__ __attribute__((aligned(16))) unsigned char shm[];
    LAS unsigned char* lds = (LAS unsigned char*)shm;
    const int bid = blockIdx.x, G = gridDim.x;
    KP kp = (KP)__builtin_amdgcn_kernarg_segment_ptr();
    const int ph_lo = kp->ph_lo, ph_hi = kp->ph_hi;
    volatile LAS unsigned* xst = (volatile LAS unsigned*)(lds + pg8::STAGE_BYTES);
    if (threadIdx.x == 0) { xst[0] = 0u; xst[1] = 0u; (void)xb_add((unsigned*)(kp->ws + O_BAR) + XB_XCNT(xb_xcc_id()), 1u); }
    __syncthreads();
    for (int ph = ph_lo; ph < ph_hi; ++ph) {
        if (ph == 0) prep_phase(kp, lds, bid, G);
        else if (ph == 2) conv_phase(kp, bid, G);
        else if (ph == 8) s5_phase(kp, lds, bid, G);
        else if (ph == 12) final_phase(kp, bid, G);
        else if (ph == 4) reduce_phase(kp, bid, G, SPLIT_G2, true);
        else if (ph == 7) reduce_phase(kp, bid, G, SPLIT_DN, false);
        else {
            size_t oa, ob, oo, oo2 = 0; int N, K, mode, S = 1;
            if (ph == 1) { oa = O_ABF; ob = O_WIN; N = 6144; K = 2048; mode = 0; oo = O_V; oo2 = O_BG; }
            else if (ph == 3) { oa = O_BG; ob = O_WOUT; N = 2048; K = 2048; mode = 1; oo = O_ABF; S = SPLIT_G2; }
            else if (ph == 5) { oa = O_ABF; ob = O_WUP0; N = 8192; K = 2048; mode = 2; oo = O_ACT; }
            else if (ph == 6) { oa = O_ACT; ob = O_WDN0; N = 2048; K = 8192; mode = 3; oo = 0; S = SPLIT_DN; }
            else if (ph == 9) { oa = O_ABF; ob = O_WGLU; N = 4096; K = 2048; mode = 4; oo = O_ABF2; }
            else if (ph == 10) { oa = O_ABF2; ob = O_WUP1; N = 8192; K = 2048; mode = 2; oo = O_ACT; }
            else { oa = O_ACT; ob = O_WDN1; N = 2048; K = 8192; mode = 3; oo = 0; S = SPLIT_DN; }
            unsigned char* ws = launder(kp)->ws;
            if ((N / 256) * (MP / 256) % G == 0 || (long)((N / 256) * (MP / 256) % G) * S > G) S = 1;
            pg8::Gemm g{(const bf16_t*)(ws + oa), (const bf16_t*)(ws + ob), MP, N, K}; pg8::StaticOrder S_; S_.init(MP, N, G, bid, S);
            LAS float* rstab = (LAS float*)(lds + pg8::STAGE_BYTES + 16);
            if (mode == 2) {
                const int t = opaque_v(threadIdx.x), row = t >> 1, hf = t & 1; const float* part = (const float*)(ws + O_PART);
                pg8::Unit u;
                for (int i = 0; i < RS_UNITS && S_.next(i, u); ++i) { const f32x4* pp = (const f32x4*)(part + (size_t)(u.pm * 256 + row) * 64 + 32 * hf); float ss = 0.f;
#pragma unroll
                    for (int k = 0; k < 8; ++k) { const f32x4 v = pp[k]; ss += (v[0] + v[1]) + (v[2] + v[3]); }
                    ss += __shfl_xor(ss, 1);
                    if (hf == 0) rstab[i * 256 + row] = rsqrtf(ss * (1.0f / D) + EPS); }
                __syncthreads();
            }
            EpiAll E{mode, (float*)(ws + O_H), (float*)(ws + O_PART), (bf16_t*)(ws + oo), (bf16_t*)(ws + oo2), ws, kp, rstab};
            pg8::gemm_phase(lds, g, S_, E);
            if (ph == 1 || ph == 5 || ph == 9 || ph == 10) { const int r = ((N / 256) * (MP / 256)) % G;
                const int j0 = ph == 1 ? 8192 : (ph == 5 ? 16384 : (ph == 9 ? 28672 : 36864)), j1 = ph == 1 ? 16384 : (ph == 5 ? 24576 : (ph == 9 ? 36864 : 45056));
                if (r == 0) filler_phase(kp, bid, G, 0, j0, j1); else if (bid >= r) filler_phase(kp, bid, G, r, j0, j1); }
        }
        if (ph + 1 < ph_hi) {
            if (ph_hi > 1000) { __syncthreads(); cg::this_grid().sync(); }
            else xcd_barrier((unsigned*)(launder(kp)->ws + O_BAR), xst);
        }
    }
}

constexpr int LDS_BYTES = pg8::STAGE_BYTES + 16 + RS_UNITS * 256 * 4;
extern "C" void kernel_launch(void* const* d_in, const int* in_sizes, int n_in, void* d_out, int out_size, void* d_ws, size_t ws_size, hipStream_t stream) {
    static int grid = 0;
    if (grid == 0) {
        if (n_in != 24 || ws_size < O_END) { fprintf(stderr, "kernel_launch: unexpected n_in %d or ws_size %zu (< %zu)\n", n_in, ws_size, (size_t)O_END); grid = -1; return; }
        int dev = 0, cus = 0, per_cu = 0;
        hipGetDevice(&dev); hipDeviceGetAttribute(&cus, hipDeviceAttributeMultiprocessorCount, dev);
        hipFuncSetAttribute((const void*)fwd_kernel, hipFuncAttributeMaxDynamicSharedMemorySize, LDS_BYTES);
        hipOccupancyMaxActiveBlocksPerMultiprocessor(&per_cu, (const void*)fwd_kernel, NTHREADS, LDS_BYTES);
        if (per_cu < 1) per_cu = 1;
        (void)hipGetLastError();
        grid = cus * 1;
        (void)per_cu;
    }
    if (grid < 0) return;
    if (hipMemsetAsync((char*)d_ws + O_BAR, 0, 16384, stream) != hipSuccess) return;
    Params p{};
    for (int i = 0; i < 24; ++i) p.in[i] = (const float*)d_in[i];
    p.out = (float*)d_out; p.ws = (unsigned char*)d_ws;
#if N_LAUNCH_MODE == 1
    p.ph_lo = 0; p.ph_hi = NPHASES;
    void* args[] = {&p};
    hipError_t e = hipLaunchCooperativeKernel((const void*)fwd_kernel, dim3(grid), dim3(NTHREADS), args, LDS_BYTES, stream);
    if (e != hipSuccess) fprintf(stderr, "cooperative launch failed: %s (grid %d)\n", hipGetErrorString(e), grid);
#else
    for (int ph = 0; ph < NPHASES; ++ph) { if (!((DBG_LAUNCH_MASK >> ph) & 1)) continue; p.ph_lo = ph; p.ph_hi = ph + 1; hipLaunchKernelGGL(fwd_kernel, dim3(grid), dim3(NTHREADS), LDS_BYTES, stream, p); }
#endif
}
```

```cpp
#include <hip/hip_runtime.h>
#include <hip/hip_cooperative_groups.h>
#include <cstdio>
namespace cg = cooperative_groups;

#ifndef PHMASK
#define PHMASK 2047
#endif
#ifndef DBG_LAUNCH_MASK
#define DBG_LAUNCH_MASK 0x1FFF
#endif
#ifndef DBL_PHASE
#define DBL_PHASE -1
#define DBL_REPS 0
#endif
#ifndef N_LAUNCH_MODE
#define N_LAUNCH_MODE 1
#endif

#define LAS __attribute__((address_space(3)))
typedef unsigned short bf16_t;
typedef short bf16x8 __attribute__((ext_vector_type(8)));
typedef float f32x4 __attribute__((ext_vector_type(4)));
typedef float f32x2 __attribute__((ext_vector_type(2)));
typedef float f32x16 __attribute__((ext_vector_type(16)));
typedef unsigned u32x4 __attribute__((ext_vector_type(4)));
typedef unsigned u32x2 __attribute__((ext_vector_type(2)));

constexpr int D = 2048, FF = 8192, LP = 2064, NB = 4, MPROMPT = NB * LP  , NSEQ = 128, MV = MPROMPT + NSEQ * 4  , MP = 8960;
constexpr int NG = 128, NST = 64;
constexpr float EPS = 1e-6f;
constexpr int NTHREADS = 512, NPHASES = 13;
constexpr int RS_UNITS = 8;
constexpr int SPLIT_G2 = 4, SPLIT_DN = 8;

constexpr size_t O_WIN = 0;
constexpr size_t O_WOUT = O_WIN + (size_t)6144 * 2048 * 2;
constexpr size_t O_WUP0 = O_WOUT + (size_t)2048 * 2048 * 2;
constexpr size_t O_WDN0 = O_WUP0 + (size_t)8192 * 2048 * 2;
constexpr size_t O_WGLU = O_WDN0 + (size_t)8192 * 2048 * 2;
constexpr size_t O_WUP1 = O_WGLU + (size_t)4096 * 2048 * 2;
constexpr size_t O_WDN1 = O_WUP1 + (size_t)8192 * 2048 * 2;
constexpr size_t O_H = O_WDN1 + (size_t)8192 * 2048 * 2;
constexpr size_t O_ABF = O_H + (size_t)MP * D * 4;
constexpr size_t O_ACT = O_ABF + (size_t)MP * D * 2;
constexpr size_t O_PART = O_ACT + (size_t)MP * FF * 2;
constexpr size_t O_ABAR = O_PART + (size_t)MP * 64 * 4;
constexpr size_t O_BFR = O_ABAR + (size_t)NG * NST * 8;
constexpr size_t O_CFR = O_BFR + (size_t)NG * 4 * 64 * 16;
constexpr size_t O_BAR = O_CFR + (size_t)NG * 4 * 64 * 16;
constexpr size_t O_END = O_BAR + 16384;
constexpr size_t O_BG = O_ACT;
constexpr size_t O_V = O_ACT + (size_t)MP * D * 2;
constexpr size_t O_ABF2 = O_WUP0;

constexpr size_t OUT_YP = 0, OUT_YS = 16777216, OUT_CONVP = 17825792, OUT_REP = 17842176, OUT_IMP = 17874944, OUT_CONVS = 17907712, OUT_RES = 18432000, OUT_IMS = 19480576;

struct Params { const float* in[24]; float* out; unsigned char* ws; int ph_lo, ph_hi; };
#if defined(__HIP_DEVICE_COMPILE__)
typedef const __attribute__((address_space(4))) Params* KP;
#else
typedef const Params* KP;
#endif
__device__ __forceinline__ KP launder(KP p) { asm volatile("" : "+s"(p)); return p; }
__device__ __forceinline__ int opaque_v(int v) { asm volatile("" : "+v"(v)); return v; }
__device__ __forceinline__ int opaque_s(int v) { asm volatile("" : "+s"(v)); return v; }

typedef __bf16 bf16x2_t __attribute__((ext_vector_type(2)));
__device__ __forceinline__ unsigned pk2(float lo, float hi) { f32x2 v = {lo, hi}; bf16x2_t b = __builtin_convertvector(v, bf16x2_t); return __builtin_bit_cast(unsigned, b); }
__device__ __forceinline__ float bf_lo(unsigned w) { return __uint_as_float(w << 16); }
__device__ __forceinline__ float bf_hi(unsigned w) { return __uint_as_float(w & 0xffff0000u); }

namespace pg8 {
constexpr int BM = 256, BK = 64, HALF = 128, HTB = HALF * BK * 2, STAGE_BYTES = 8 * HTB, NXCD = 8, WGM = 8;
__device__ __forceinline__ int lds_byte(int r, int c) { const int st = (r >> 4) * 2 + (c >> 5), rr = r & 15, cc = c & 31, ob = rr * 64 + cc * 2; return st * 1024 + (ob ^ (((ob >> 9) & 1) << 5)); }
__device__ __forceinline__ void stage_rc(int b, int& R, int& C) { const int st = b / 1024, sb = b % 1024, swz = sb ^ (((sb >> 9) & 1) << 5); R = (st >> 1) * 16 + swz / 64; C = (st & 1) * 32 + (swz % 64) / 2; }
__device__ __forceinline__ int perm32(int rho) { const int n = rho >> 4, i = rho & 15; return 8 * (i >> 2) + 4 * n + (i & 3); }
struct Unit { int pm, pn, ks, slot; };
struct Gemm { const bf16_t* A; const bf16_t* Bt; int M, N, K; };
struct StaticOrder {
    int nM, nN, nwg, G, c, S, nfull;
    __device__ void init(int M, int N, int G_, int c_, int S_) { nM = M / BM; nN = N / BM; nwg = nM * nN; G = G_; c = c_; S = S_; nfull = (S_ > 1) ? (nwg / G_) * G_ : nwg; }
    __device__ void map(int wgid, Unit& u) const {
        { const int q = nwg / NXCD, r = nwg % NXCD, xcd = wgid % NXCD, off = wgid / NXCD; wgid = (xcd < r ? xcd * (q + 1) : r * (q + 1) + (xcd - r) * q) + off; }
        const int nig = WGM * nN, gid = wgid / nig, fm = gid * WGM, gsz = (nM - fm) < WGM ? (nM - fm) : WGM;
        u.pm = fm + ((wgid % nig) % gsz); u.pn = (wgid % nig) / gsz;
    }
    __device__ bool next(int i, Unit& u) const {
        const long L = (long)i * G + c;
        if (L < nfull) { map((int)L, u); u.ks = -1; u.slot = i; return true; }
        const long j = L - nfull; if (j >= (long)(nwg - nfull) * S) return false;
        map(nfull + (int)j / S, u); u.ks = (int)j % S; u.slot = (int)j; return true;
    }
};

template <class Epi>
__device__ __forceinline__ void gemm_phase(LAS unsigned char* lds, const Gemm g, const StaticOrder& S, const Epi& E) {
    const int tid = opaque_v(threadIdx.x), wid = __builtin_amdgcn_readfirstlane(tid >> 6), lane = tid & 63, wr = wid >> 2, wc = wid & 3, fr = lane & 15, fq = lane >> 4;
    const int K = g.K, KS = K / S.S;
    unsigned voffA[2], voffB[2];
#pragma unroll
    for (int i = 0; i < 2; ++i) { int R, C; stage_rc(tid * 16 + i * 8192, R, C); const int Rb = (R & ~31) + perm32(R & 31);
        voffA[i] = (unsigned)(R * K + C) * 2u; voffB[i] = (unsigned)(Rb * K + C) * 2u; }
    const size_t kstep = (size_t)(BK * 2);
    const size_t hstep = (size_t)HALF * K * 2;
    const size_t tstep = 2 * hstep;
    const unsigned ldsw = (unsigned)wid * 1024u;
    const int aoff = lds_byte(wr * 64 + fr, fq * 8), boff = lds_byte(wc * 32 + fr, fq * 8);
#define PG8_SA(b, h) (((b) * 2 + (h)) * HTB)
#define PG8_SB(b, h) ((4 + (b) * 2 + (h)) * HTB)
#define PG8_STAGE(bufoff, gbase, voff) do { _Pragma("unroll") for (int _i = 0; _i < 2; ++_i) \
        __builtin_amdgcn_global_load_lds((const unsigned*)((const char*)(gbase) + (voff)[_i]), (LAS unsigned*)(lds + (bufoff) + ldsw + _i * 8192), 16, 0, 0); } while (0)
#define PG8_LDA(dst, b, h) do { _Pragma("unroll") for (int m = 0; m < 4; ++m) _Pragma("unroll") for (int k = 0; k < 2; ++k) dst[m][k] = *(const LAS bf16x8*)(lds + PG8_SA(b, h) + aoff + m * 2048 + k * 1024); } while (0)
#define PG8_LDB(dst, b, h) do { _Pragma("unroll") for (int n = 0; n < 2; ++n) _Pragma("unroll") for (int k = 0; k < 2; ++k) dst[n][k] = *(const LAS bf16x8*)(lds + PG8_SB(b, h) + boff + n * 2048 + k * 1024); } while (0)
#define PG8_MMA(ai, bj, At, Bt) do { __builtin_amdgcn_s_setprio(1); _Pragma("unroll") for (int m = 0; m < 4; ++m) _Pragma("unroll") for (int n = 0; n < 2; ++n) _Pragma("unroll") for (int k = 0; k < 2; ++k) \
        acc[ai][bj][m][n] = __builtin_amdgcn_mfma_f32_16x16x32_bf16(Bt[n][k], At[m][k], acc[ai][bj][m][n], 0, 0, 0); __builtin_amdgcn_s_setprio(0); } while (0)
#define PG8_WAIT_V(n) asm volatile("s_waitcnt vmcnt(" #n ")" ::: "memory")
#define PG8_WAIT_L(n) asm volatile("s_waitcnt lgkmcnt(" #n ")" ::: "memory")
#define PG8_BAR __builtin_amdgcn_s_barrier()
#define PG8_SCHED __builtin_amdgcn_sched_barrier(0)
    Unit cur, nxt; int ui = 0;
    if (!S.next(0, cur)) return;
    f32x4 acc[2][2][4][2];
#pragma unroll
    for (int a = 0; a < 2; ++a)
#pragma unroll
        for (int b = 0; b < 2; ++b)
#pragma unroll
            for (int m = 0; m < 4; ++m)
#pragma unroll
                for (int n = 0; n < 2; ++n) acc[a][b][m][n] = (f32x4){0.f, 0.f, 0.f, 0.f};
    bf16x8 At[4][2], B0[2][2], B1[2][2];
    size_t koff = cur.ks < 0 ? 0 : (size_t)cur.ks * KS * 2; int nt = (cur.ks < 0 ? K : KS) / BK;
    const char* cA = (const char*)g.A + (size_t)cur.pm * tstep + koff; const char* cB = (const char*)g.Bt + (size_t)cur.pn * tstep + koff;
    PG8_STAGE(PG8_SB(0, 0), cB, voffB); PG8_STAGE(PG8_SA(0, 0), cA, voffA); PG8_STAGE(PG8_SB(0, 1), cB + hstep, voffB); PG8_STAGE(PG8_SA(0, 1), cA + hstep, voffA);
    if (wr == 1) PG8_BAR;
    PG8_WAIT_V(4); PG8_BAR;
    PG8_STAGE(PG8_SB(1, 0), cB + kstep, voffB); PG8_STAGE(PG8_SA(1, 0), cA + kstep, voffA); PG8_STAGE(PG8_SB(1, 1), cB + hstep + kstep, voffB);
    PG8_WAIT_V(6); PG8_BAR;
    for (;;) {
        const bool has_next = S.next(ui + 1, nxt);
        const size_t nkoff = (has_next && nxt.ks >= 0) ? (size_t)nxt.ks * KS * 2 : 0;
        const char* nA = has_next ? (const char*)g.A + (size_t)nxt.pm * tstep + nkoff : cA; const char* nB = has_next ? (const char*)g.Bt + (size_t)nxt.pn * tstep + nkoff : cB;
        for (int t = 0; t < nt; t += 2) {
            const bool last = (t == nt - 2);
            const char* a1 = cA + (size_t)(t + 1) * kstep;
            const char* a2 = last ? nA : cA + (size_t)(t + 2) * kstep; const char* b2 = last ? nB : cB + (size_t)(t + 2) * kstep;
            const char* a3 = a2 + kstep; const char* b3 = b2 + kstep;
            PG8_LDB(B0, 0, 0); PG8_SCHED; PG8_LDA(At, 0, 0); PG8_STAGE(PG8_SA(1, 1), a1 + hstep, voffA);
            PG8_WAIT_L(8); PG8_BAR; PG8_WAIT_L(0); PG8_MMA(0, 0, At, B0); PG8_BAR; PG8_SCHED;
            PG8_LDB(B1, 0, 1); PG8_STAGE(PG8_SB(0, 0), b2, voffB);
            PG8_BAR; PG8_WAIT_L(0); PG8_MMA(0, 1, At, B1); PG8_BAR;
            PG8_LDA(At, 0, 1); PG8_STAGE(PG8_SA(0, 0), a2, voffA);
            PG8_BAR; PG8_WAIT_L(0); PG8_MMA(1, 0, At, B0); PG8_BAR; PG8_SCHED;
            PG8_STAGE(PG8_SB(0, 1), b2 + hstep, voffB);
            PG8_WAIT_V(6); PG8_BAR; PG8_MMA(1, 1, At, B1); PG8_BAR;
            PG8_LDB(B0, 1, 0); PG8_SCHED; PG8_LDA(At, 1, 0); PG8_STAGE(PG8_SA(0, 1), a2 + hstep, voffA);
            PG8_WAIT_L(8); PG8_BAR; PG8_WAIT_L(0); PG8_MMA(0, 0, At, B0); PG8_BAR; PG8_SCHED;
            PG8_LDB(B1, 1, 1); PG8_STAGE(PG8_SB(1, 0), b3, voffB);
            PG8_BAR; PG8_WAIT_L(0); PG8_MMA(0, 1, At, B1); PG8_BAR;
            PG8_LDA(At, 1, 1); PG8_STAGE(PG8_SA(1, 0), a3, voffA);
            PG8_BAR; PG8_WAIT_L(0); PG8_MMA(1, 0, At, B0); PG8_BAR; PG8_SCHED;
            PG8_STAGE(PG8_SB(1, 1), b3 + hstep, voffB);
            PG8_WAIT_V(6); PG8_BAR; PG8_MMA(1, 1, At, B1); PG8_BAR;
        }
        E(acc, cur, wr, wc, fr, fq);
        if (!has_next) break;
#pragma unroll
        for (int a = 0; a < 2; ++a)
#pragma unroll
            for (int b = 0; b < 2; ++b)
#pragma unroll
                for (int m = 0; m < 4; ++m)
#pragma unroll
                    for (int n = 0; n < 2; ++n) acc[a][b][m][n] = (f32x4){0.f, 0.f, 0.f, 0.f};
        cur = nxt; cA = nA; cB = nB; ++ui; nt = (cur.ks < 0 ? K : KS) / BK;
    }
    PG8_WAIT_V(0);
    if (wr == 0) PG8_BAR;
    PG8_BAR;
#undef PG8_SA
#undef PG8_SB
#undef PG8_STAGE
#undef PG8_LDA
#undef PG8_LDB
#undef PG8_MMA
#undef PG8_WAIT_V
#undef PG8_WAIT_L
#undef PG8_BAR
#undef PG8_SCHED
}
}

__device__ __forceinline__ u32x4 pack8(const f32x4 a, const f32x4 b) { u32x4 w; w.x = pk2(a[0], a[1]); w.y = pk2(a[2], a[3]); w.z = pk2(b[0], b[1]); w.w = pk2(b[2], b[3]); return w; }

struct EpiG1 {
    bf16_t* V; bf16_t* BG;
    __device__ __forceinline__ void operator()(const f32x4 (&acc)[2][2][4][2], const pg8::Unit& u, int wr, int wc, int fr, int fq) const {
        const int row0 = u.pm * 256 + wr * 64 + fr;
        if (u.pn < 16) {
            const int ch0 = 128 * u.pn + 32 * wc + 8 * fq;
#pragma unroll
            for (int ai = 0; ai < 2; ++ai)
#pragma unroll
                for (int m = 0; m < 4; ++m) { const size_t r = row0 + ai * 128 + m * 16;
                    *(u32x4*)(V + r * D + ch0) = pack8(acc[ai][0][m][0] * acc[ai][1][m][0], acc[ai][0][m][1] * acc[ai][1][m][1]); }
        } else {
            const int c0 = 256 * (u.pn - 16) + 32 * wc + 8 * fq;
#pragma unroll
            for (int ai = 0; ai < 2; ++ai)
#pragma unroll
                for (int m = 0; m < 4; ++m) { const size_t r = row0 + ai * 128 + m * 16;
#pragma unroll
                    for (int bj = 0; bj < 2; ++bj) *(u32x4*)(BG + r * D + c0 + 128 * bj) = pack8(acc[ai][bj][m][0], acc[ai][bj][m][1]); }
        }
    }
};
__device__ __forceinline__ const float* xsrc(KP kp, int row) {
    if (row < MPROMPT) { const int b = row / LP, pos = row - b * LP; return pos < 16 ? kp->in[5] + (size_t)pos * D : kp->in[0] + ((size_t)b * 2048 + (pos - 16)) * D; }
    if (row < MV) return kp->in[1] + (size_t)(row - MPROMPT) * D;
    return kp->in[5];
}
template <bool WBF> struct EpiRes {
    float* H; float* part; bf16_t* O; KP kp;
    __device__ __forceinline__ void operator()(const f32x4 (&acc)[2][2][4][2], const pg8::Unit& u, int wr, int wc, int fr, int fq) const {
        const int row0 = u.pm * 256 + wr * 64 + fr, c0 = 256 * u.pn + 32 * wc + 8 * fq;
#pragma unroll
        for (int ai = 0; ai < 2; ++ai) {
            f32x4 rv[4][2][2];
#pragma unroll
            for (int m = 0; m < 4; ++m) { const size_t r = row0 + ai * 128 + m * 16;
                const float* rp = WBF ? xsrc(kp, (int)r) + c0 : H + r * D + c0;
#pragma unroll
                for (int bj = 0; bj < 2; ++bj) { rv[m][bj][0] = *(const f32x4*)(rp + 128 * bj); rv[m][bj][1] = *(const f32x4*)(rp + 128 * bj + 4); } }
#pragma unroll
            for (int m = 0; m < 4; ++m) { const size_t r = row0 + ai * 128 + m * 16;
#pragma unroll
                for (int bj = 0; bj < 2; ++bj) { float* hp = H + r * D + c0 + 128 * bj;
                    const f32x4 h0 = rv[m][bj][0] + acc[ai][bj][m][0], h1 = rv[m][bj][1] + acc[ai][bj][m][1];
                    *(f32x4*)hp = h0; *(f32x4*)(hp + 4) = h1;
                    float ss = (h0[0] * h0[0] + h0[1] * h0[1]) + (h0[2] * h0[2] + h0[3] * h0[3]) + (h1[0] * h1[0] + h1[1] * h1[1]) + (h1[2] * h1[2] + h1[3] * h1[3]);
                    ss += __shfl_xor(ss, 16); ss += __shfl_xor(ss, 32);
                    if (fq == 0) part[r * 64 + 8 * u.pn + 4 * bj + wc] = ss;
                    if (WBF) *(u32x4*)(O + r * D + c0 + 128 * bj) = pack8(h0, h1); } }
            asm volatile("" ::: "memory"); }
    }
};
struct EpiUp {
    const LAS float* rstab; bf16_t* O;
    __device__ __forceinline__ void operator()(const f32x4 (&acc)[2][2][4][2], const pg8::Unit& u, int wr, int wc, int fr, int fq) const {
        const int row0 = u.pm * 256 + wr * 64 + fr, c0 = 256 * u.pn + 32 * wc + 8 * fq;
        const LAS float* rt = rstab + u.slot * 256 + wr * 64 + fr;
#pragma unroll
        for (int ai = 0; ai < 2; ++ai) {
#pragma unroll
            for (int m = 0; m < 4; ++m) { const size_t r = row0 + ai * 128 + m * 16; const float rs = rt[ai * 128 + m * 16];
#pragma unroll
                for (int bj = 0; bj < 2; ++bj) { f32x4 a0 = acc[ai][bj][m][0] * rs, a1 = acc[ai][bj][m][1] * rs;
#pragma unroll
                    for (int e = 0; e < 4; ++e) { a0[e] = fmaxf(a0[e], 0.f); a0[e] *= a0[e]; a1[e] = fmaxf(a1[e], 0.f); a1[e] *= a1[e]; }
                    *(u32x4*)(O + r * FF + c0 + 128 * bj) = pack8(a0, a1); } } }
    }
};
struct EpiGlu {
    float* H; float* part; bf16_t* O;
    __device__ __forceinline__ void operator()(const f32x4 (&acc)[2][2][4][2], const pg8::Unit& u, int wr, int wc, int fr, int fq) const {
        const int row0 = u.pm * 256 + wr * 64 + fr, ch0 = 128 * u.pn + 32 * wc + 8 * fq;
#pragma unroll
        for (int ai = 0; ai < 2; ++ai) {
            f32x4 rv[4][2];
#pragma unroll
            for (int m = 0; m < 4; ++m) { const float* hp = H + (size_t)(row0 + ai * 128 + m * 16) * D + ch0; rv[m][0] = *(const f32x4*)hp; rv[m][1] = *(const f32x4*)(hp + 4); }
#pragma unroll
            for (int m = 0; m < 4; ++m) { const size_t r = row0 + ai * 128 + m * 16;
                float* hp = H + r * D + ch0;
                f32x4 h0 = rv[m][0], h1 = rv[m][1];
#pragma unroll
                for (int e = 0; e < 4; ++e) { h0[e] += acc[ai][0][m][0][e] * __builtin_amdgcn_rcpf(1.0f + __expf(-acc[ai][1][m][0][e])); h1[e] += acc[ai][0][m][1][e] * __builtin_amdgcn_rcpf(1.0f + __expf(-acc[ai][1][m][1][e])); }
                *(f32x4*)hp = h0; *(f32x4*)(hp + 4) = h1;
                float ss = (h0[0] * h0[0] + h0[1] * h0[1]) + (h0[2] * h0[2] + h0[3] * h0[3]) + (h1[0] * h1[0] + h1[1] * h1[1]) + (h1[2] * h1[2] + h1[3] * h1[3]);
                ss += __shfl_xor(ss, 16); ss += __shfl_xor(ss, 32);
                if (fq == 0) part[r * 64 + 4 * u.pn + wc] = ss;
                *(u32x4*)(O + r * D + ch0) = pack8(h0, h1); }
            asm volatile("" ::: "memory"); }
    }
};

__device__ __forceinline__ void job_info(KP P_, int j, const float*& src, int& Nsrc, const float*& gain, bf16_t*& dst, int& K, int& k0, int& n0) {
    int mode, ndt; const float* src2 = nullptr; unsigned char* ws = P_->ws;
    if (j < 6144) { src = P_->in[9]; Nsrc = 6144; gain = P_->in[6]; dst = (bf16_t*)(ws + O_WIN); K = 2048; ndt = 96; mode = 1; }
    else if (j < 8192) { j -= 6144; src = P_->in[11]; Nsrc = 2048; gain = nullptr; dst = (bf16_t*)(ws + O_WOUT); K = 2048; ndt = 32; mode = 0; }
    else if (j < 16384) { j -= 8192; src = P_->in[22]; Nsrc = 8192; gain = P_->in[7]; dst = (bf16_t*)(ws + O_WUP0); K = 2048; ndt = 128; mode = 0; }
    else if (j < 24576) { j -= 16384; src = P_->in[23]; Nsrc = 2048; gain = nullptr; dst = (bf16_t*)(ws + O_WDN0); K = 8192; ndt = 32; mode = 0; }
    else if (j < 28672) { j -= 24576; src = P_->in[20]; src2 = P_->in[21]; Nsrc = 2048; gain = nullptr; dst = (bf16_t*)(ws + O_WGLU); K = 2048; ndt = 64; mode = 2; }
    else if (j < 36864) { j -= 28672; src = P_->in[22] + (size_t)2048 * 8192; Nsrc = 8192; gain = P_->in[7] + 2048; dst = (bf16_t*)(ws + O_WUP1); K = 2048; ndt = 128; mode = 0; }
    else { j -= 36864; src = P_->in[23] + (size_t)8192 * 2048; Nsrc = 2048; gain = nullptr; dst = (bf16_t*)(ws + O_WDN1); K = 8192; ndt = 32; mode = 0; }
    const int nb = j % ndt, kc = j / ndt; k0 = kc * 32; n0 = nb * 64;
    int col = n0;
    if (mode == 1) { if (n0 < 4096) { const int pn = n0 >> 8, bj = (n0 >> 7) & 1, j0 = n0 & 127; col = (bj ? 4096 : 2048) + 128 * pn + j0; } else col = n0 - 4096; }
    if (mode == 2) { const int pn = n0 >> 8, bj = (n0 >> 7) & 1, j0 = n0 & 127; col = 128 * pn + j0; if (bj) src = src2; }
    src += col;
}
constexpr int NJOBS = 45056, NJOBS_L0 = 24576, NJOBS_F1 = 31744, NJOBS_F2 = 38912;
__device__ __forceinline__ void convert_jobs(KP kp, int j0, int j1, int widx, int nw, int lane) {
    for (int j = j0 + widx; j < j1; j += nw) {
        const float* src; int Nsrc; const float* gain; bf16_t* dst; int K, k0, n0;
        job_info(kp, j, src, Nsrc, gain, dst, K, k0, n0);
        const float* sp = src + (size_t)k0 * Nsrc + lane;
        float v[32];
#pragma unroll
        for (int i = 0; i < 32; ++i) v[i] = sp[(size_t)i * Nsrc];
        if (gain) {
#pragma unroll
            for (int i = 0; i < 32; ++i) v[i] *= gain[k0 + i]; }
        bf16_t* dp = dst + (size_t)(n0 + lane) * K + k0;
#pragma unroll
        for (int o = 0; o < 4; ++o) { u32x4 w; w.x = pk2(v[8 * o], v[8 * o + 1]); w.y = pk2(v[8 * o + 2], v[8 * o + 3]); w.z = pk2(v[8 * o + 4], v[8 * o + 5]); w.w = pk2(v[8 * o + 6], v[8 * o + 7]);
            *(u32x4*)(dp + 8 * o) = w; }
    }
}
__device__ __forceinline__ void filler_phase(KP kp, int bid, int G, int r, int j0, int j1) {
    kp = launder(kp); bid = opaque_s(bid); G = opaque_s(G);
    const int tid = opaque_v(threadIdx.x), lane = tid & 63, wv = __builtin_amdgcn_readfirstlane(tid >> 6);
    convert_jobs(kp, j0, j1, (bid - r) * 8 + wv, (G - r) * 8, lane);
}
__device__ __forceinline__ void prep_phase(KP kp, LAS unsigned char* lds, int bid, int G) {
    kp = launder(kp); bid = opaque_s(bid); G = opaque_s(G);
    const int tid = opaque_v(threadIdx.x), lane = tid & 63, wave = tid >> 6;
    convert_jobs(kp, 0, 6144, bid * 8 + __builtin_amdgcn_readfirstlane(wave), 8 * G, lane);
    if (false) {
        const int wv = __builtin_amdgcn_readfirstlane(wave);
        for (int j = bid * 8 + wv; j < NJOBS; j += 8 * G) {
            const float* src; int Nsrc; const float* gain; bf16_t* dst; int K, k0, n0;
            job_info(kp, j, src, Nsrc, gain, dst, K, k0, n0);
            const float* sp = src + (size_t)k0 * Nsrc + lane;
            float v[32];
#pragma unroll
            for (int i = 0; i < 32; ++i) v[i] = sp[(size_t)i * Nsrc];
            if (gain) {
#pragma unroll
                for (int i = 0; i < 32; ++i) v[i] *= gain[k0 + i]; }
            bf16_t* dp = dst + (size_t)(n0 + lane) * K + k0;
#pragma unroll
            for (int o = 0; o < 4; ++o) { u32x4 w; w.x = pk2(v[8 * o], v[8 * o + 1]); w.y = pk2(v[8 * o + 2], v[8 * o + 3]); w.z = pk2(v[8 * o + 4], v[8 * o + 5]); w.w = pk2(v[8 * o + 6], v[8 * o + 7]);
                *(u32x4*)(dp + 8 * o) = w; }
        }
    }
    {   const Params P = *launder(kp);
        float* H = (float*)(P.ws + O_H); bf16_t* A = (bf16_t*)(P.ws + O_ABF);
        for (int row = wave * G + bid; row < MP; row += 8 * G) {
            const float* xs = nullptr;
            if (row < MPROMPT) { const int b = row / LP, pos = row % LP; xs = pos < 16 ? P.in[5] + (size_t)pos * D : P.in[0] + ((size_t)b * 2048 + (pos - 16)) * D; }
            else if (row < MV) xs = P.in[1] + (size_t)(row - MPROMPT) * D;
            f32x4 v[8]; float ss = 0.f;
#pragma unroll
            for (int j = 0; j < 8; ++j) { v[j] = xs ? *(const f32x4*)(xs + 4 * lane + 256 * j) : (f32x4){0.f, 0.f, 0.f, 0.f}; ss += (v[j][0] * v[j][0] + v[j][1] * v[j][1]) + (v[j][2] * v[j][2] + v[j][3] * v[j][3]); }
#pragma unroll
            for (int o = 1; o < 64; o <<= 1) ss += __shfl_xor(ss, o);
            const float rs = rsqrtf(ss * (1.0f / D) + EPS);
#pragma unroll
            for (int j = 0; j < 8; ++j) {
                u32x2 w; w.x = pk2(v[j][0] * rs, v[j][1] * rs); w.y = pk2(v[j][2] * rs, v[j][3] * rs); *(u32x2*)(A + (size_t)row * D + 4 * lane + 256 * j) = w; }
        }
    }
    {   const Params P = *launder(kp);
        const int gt = bid * NTHREADS + tid, NT = G * NTHREADS;
        for (int i = gt; i < NG * NST; i += NT) { const int g = i >> 6, p = i & 63;
            const float dt = expf(P.in[14][g]), lr = P.in[12][i], li = P.in[13][i];
            const float mag = expf(lr * dt), are = mag * cosf(li * dt), aim = mag * sinf(li * dt);
            ((f32x2*)(P.ws + O_ABAR))[i] = (f32x2){are, aim};
            const float nr = are - 1.0f, ni = aim, den = lr * lr + li * li, qre = (nr * lr + ni * li) / den, qim = (ni * lr - nr * li) / den;
            const float* bre = P.in[15] + (size_t)i * 16; const float* bim = P.in[16] + (size_t)i * 16;
            bf16_t* BF = (bf16_t*)(P.ws + O_BFR);
#pragma unroll
            for (int ch = 0; ch < 2; ++ch) { f32x4 r0 = *(const f32x4*)(bre + 8 * ch), r1 = *(const f32x4*)(bre + 8 * ch + 4), i0 = *(const f32x4*)(bim + 8 * ch), i1 = *(const f32x4*)(bim + 8 * ch + 4);
                const f32x4 o0 = r0 * qre - i0 * qim, o1 = r1 * qre - i1 * qim, m0 = i0 * qre + r0 * qim, m1 = i1 * qre + r1 * qim;
                const int ln = (p & 31) + 32 * ch, blk = p >> 5;
                *(u32x4*)(BF + ((size_t)(g * 4 + blk) * 64 + ln) * 8) = pack8(o0, o1);
                *(u32x4*)(BF + ((size_t)(g * 4 + 2 + blk) * 64 + ln) * 8) = pack8(m0, m1); }
        }
        for (int i = gt; i < NG * 4 * 64; i += NT) { const int g = i >> 8, kk = (i >> 6) & 3, l = i & 63, c = l & 15, p0 = 16 * kk + 4 * (l >> 4);
            const f32x4 cr = *(const f32x4*)(P.in[17] + ((size_t)g * 16 + c) * 64 + p0), ci = *(const f32x4*)(P.in[18] + ((size_t)g * 16 + c) * 64 + p0);
            u32x4 w; w.x = pk2(cr[0], -ci[0]); w.y = pk2(cr[1], -ci[1]); w.z = pk2(cr[2], -ci[2]); w.w = pk2(cr[3], -ci[3]);
            *(u32x4*)((bf16_t*)(P.ws + O_CFR) + (size_t)i * 8) = w; }
    }
}

__device__ __forceinline__ void unpack8(const u32x4 w, float (&f)[8]) { f[0] = bf_lo(w.x); f[1] = bf_hi(w.x); f[2] = bf_lo(w.y); f[3] = bf_hi(w.y); f[4] = bf_lo(w.z); f[5] = bf_hi(w.z); f[6] = bf_lo(w.w); f[7] = bf_hi(w.w); }
__device__ __forceinline__ void conv_phase(KP kp, int bid, int G) {
    const Params P = *launder(kp); bid = opaque_s(bid); G = opaque_s(G);
    const int tid = opaque_v(threadIdx.x), half = tid >> 8, ch = (tid & 255) * 8;
    bf16_t* BG = (bf16_t*)(P.ws + O_BG); const bf16_t* V = (const bf16_t*)(P.ws + O_V);
    float w0[8], w1[8], w2[8];
#pragma unroll
    for (int e = 0; e < 8; ++e) { w0[e] = P.in[10][ch + e]; w1[e] = P.in[10][D + ch + e]; w2[e] = P.in[10][2 * D + ch + e]; }
    for (int item = half * G + bid; item < MV / 8; item += 2 * G) {
        const int row0 = item * 8; const bool smp = row0 >= MPROMPT;
        const int b = smp ? 0 : row0 / LP, pos0 = smp ? 0 : row0 - b * LP, seq0 = smp ? (row0 - MPROMPT) / 4 : 0;
        u32x4 vq[8], bq[8];
#pragma unroll
        for (int r = 0; r < 8; ++r) { vq[r] = *(const u32x4*)(V + (size_t)(row0 + r) * D + ch); bq[r] = *(const u32x4*)(BG + (size_t)(row0 + r) * D + ch); }
        float vm2[8], vm1[8], sm2[8], sm1[8];
        if (smp) { const float* st = P.in[2] + (size_t)seq0 * 2 * D + ch;
#pragma unroll
            for (int e = 0; e < 8; ++e) { vm2[e] = st[e]; vm1[e] = st[D + e]; sm2[e] = st[2 * D + e]; sm1[e] = st[3 * D + e]; } }
        else if (pos0 == 0) {
#pragma unroll
            for (int e = 0; e < 8; ++e) { vm2[e] = 0.f; vm1[e] = 0.f; sm2[e] = 0.f; sm1[e] = 0.f; } }
        else { unpack8(*(const u32x4*)(V + (size_t)(row0 - 2) * D + ch), vm2); unpack8(*(const u32x4*)(V + (size_t)(row0 - 1) * D + ch), vm1);
#pragma unroll
            for (int e = 0; e < 8; ++e) { sm2[e] = 0.f; sm1[e] = 0.f; } }
#pragma unroll
        for (int r = 0; r < 8; ++r) {
            if (r == 4 && smp) {
                float* o = P.out + OUT_CONVS + (size_t)seq0 * 2 * D + ch;
                *(f32x4*)o = (f32x4){vm2[0], vm2[1], vm2[2], vm2[3]}; *(f32x4*)(o + 4) = (f32x4){vm2[4], vm2[5], vm2[6], vm2[7]};
                *(f32x4*)(o + D) = (f32x4){vm1[0], vm1[1], vm1[2], vm1[3]}; *(f32x4*)(o + D + 4) = (f32x4){vm1[4], vm1[5], vm1[6], vm1[7]};
#pragma unroll
                for (int e = 0; e < 8; ++e) { vm2[e] = sm2[e]; vm1[e] = sm1[e]; } }
            float v[8], bg[8]; unpack8(vq[r], v); unpack8(bq[r], bg);
            f32x4 o0, o1;
#pragma unroll
            for (int e = 0; e < 4; ++e) { o0[e] = bg[e] * (w0[e] * vm2[e] + w1[e] * vm1[e] + w2[e] * v[e]); o1[e] = bg[e + 4] * (w0[e + 4] * vm2[e + 4] + w1[e + 4] * vm1[e + 4] + w2[e + 4] * v[e + 4]); }
            *(u32x4*)(BG + (size_t)(row0 + r) * D + ch) = pack8(o0, o1);
#pragma unroll
            for (int e = 0; e < 8; ++e) { vm2[e] = vm1[e]; vm1[e] = v[e]; } }
        if (smp || pos0 + 8 == LP) { float* o = smp ? P.out + OUT_CONVS + (size_t)(seq0 + 1) * 2 * D + ch : P.out + OUT_CONVP + (size_t)b * 2 * D + ch;
            *(f32x4*)o = (f32x4){vm2[0], vm2[1], vm2[2], vm2[3]}; *(f32x4*)(o + 4) = (f32x4){vm2[4], vm2[5], vm2[6], vm2[7]};
            *(f32x4*)(o + D) = (f32x4){vm1[0], vm1[1], vm1[2], vm1[3]}; *(f32x4*)(o + D + 4) = (f32x4){vm1[4], vm1[5], vm1[6], vm1[7]}; }
    }
}

constexpr int S5_CUT = 44;
constexpr int S5_PITCH = 68, S5_UP = 20, S5_RSQ_BYTES = 2112 * 4, S5_WLDS = 32 * S5_PITCH * 4 + 32 * S5_UP * 4 + 128;
template <int MODE>
__device__ __forceinline__ void s5_job(const Params& P, LAS unsigned char* lds, LAS unsigned char* wl, int lane, int g, int idx, int ck0, int ck1, float& hr, float& hi) {
    constexpr bool SAMPLE = (MODE == 1), LIGHT = (MODE == 2);
    const float* Hb = (const float*)(P.ws + O_H); const float* part = (const float*)(P.ws + O_PART); bf16_t* GA = (bf16_t*)(P.ws + O_ABF);
    const int t32 = lane & 31, hlf = lane >> 5, t16 = lane & 15, q = lane >> 4;
    const f32x2 ab = ((const f32x2*)(P.ws + O_ABAR))[g * 64 + lane]; const float ar = ab[0], ai = ab[1];
    bf16x8 Bf[4], Cf[4];
#pragma unroll
    for (int i = 0; i < 4; ++i) { Bf[i] = ((const bf16x8*)(P.ws + O_BFR))[(g * 4 + i) * 64 + lane]; if (!LIGHT) Cf[i] = ((const bf16x8*)(P.ws + O_CFR))[(g * 4 + i) * 64 + lane]; }
    const float* gn = P.in[6] + D;
    const f32x4 gnA0 = *(const f32x4*)(gn + 16 * g + 8 * hlf), gnA1 = *(const f32x4*)(gn + 16 * g + 8 * hlf + 4);
    const f32x4 z4 = (f32x4){0.f, 0.f, 0.f, 0.f};
    const f32x4 dE = LIGHT ? z4 : *(const f32x4*)(P.in[19] + 16 * g + 4 * q);
    const LAS float* rsq = (const LAS float*)lds;
    LAS unsigned* Hp = (LAS unsigned*)wl; LAS float* U = (LAS float*)(wl + 32 * S5_PITCH * 4);
    float c15r = 0.f, c15i = 0.f;
    const int rowbase = SAMPLE ? MPROMPT + 32 * idx : idx * LP;
    f32x4 x0 = z4, x1 = z4;
    { const size_t row = rowbase + 32 * ck0 + t32; x0 = *(const f32x4*)(Hb + row * D + 16 * g + 8 * hlf); x1 = *(const f32x4*)(Hb + row * D + 16 * g + 8 * hlf + 4); }
    for (int ck = ck0; ck < ck1; ++ck) {
        const int row0 = rowbase + 32 * ck, nvalid = SAMPLE ? 32 : (LP - 32 * ck < 32 ? LP - 32 * ck : 32);
        float rs;
        if (SAMPLE) { const size_t row = row0 + t32; float ss = 0.f; const f32x4* pp = (const f32x4*)(part + row * 64 + 32 * hlf);
#pragma unroll
            for (int i = 0; i < 8; ++i) { const f32x4 v = pp[i]; ss += (v[0] + v[1]) + (v[2] + v[3]); }
            ss += __shfl_xor(ss, 32); rs = rsqrtf(ss * (1.0f / D) + EPS); }
        else rs = rsq[32 * ck + t32];
        f32x4 u0 = x0 * rs * gnA0, u1 = x1 * rs * gnA1;
        if (!SAMPLE && t32 >= nvalid) { u0 = z4; u1 = z4; }
        if (SAMPLE && hlf == 0) U[t32 * S5_UP + 16] = rs;
        union { u32x4 u; bf16x8 b; } af; af.u = pack8(u0, u1);
        if (!SAMPLE && ck + 1 < ck1) {
            const size_t row = row0 + 32 + t32; x0 = *(const f32x4*)(Hb + row * D + 16 * g + 8 * hlf); x1 = *(const f32x4*)(Hb + row * D + 16 * g + 8 * hlf + 4); }
        const f32x16 z16 = {0.f, 0.f, 0.f, 0.f, 0.f, 0.f, 0.f, 0.f, 0.f, 0.f, 0.f, 0.f, 0.f, 0.f, 0.f, 0.f};
        f32x16 R0 = __builtin_amdgcn_mfma_f32_32x32x16_bf16(af.b, Bf[0], z16, 0, 0, 0);
        f32x16 R1 = __builtin_amdgcn_mfma_f32_32x32x16_bf16(af.b, Bf[1], z16, 0, 0, 0);
        f32x16 I0 = __builtin_amdgcn_mfma_f32_32x32x16_bf16(af.b, Bf[2], z16, 0, 0, 0);
        f32x16 I1 = __builtin_amdgcn_mfma_f32_32x32x16_bf16(af.b, Bf[3], z16, 0, 0, 0);
#pragma unroll
        for (int i = 0; i < 16; ++i) {
            auto sr = __builtin_amdgcn_permlane32_swap(__float_as_uint(R0[i]), __float_as_uint(R1[i]), false, false); R0[i] = __uint_as_float(sr[0]); R1[i] = __uint_as_float(sr[1]);
            auto si = __builtin_amdgcn_permlane32_swap(__float_as_uint(I0[i]), __float_as_uint(I1[i]), false, false); I0[i] = __uint_as_float(si[0]); I1[i] = __uint_as_float(si[1]); }
        float h0r[8], h0i[8];
        if (SAMPLE) {
#pragma unroll
            for (int s = 0; s < 8; ++s) { const size_t o = ((size_t)(8 * idx + s) * NG + g) * NST + lane; h0r[s] = P.in[3][o]; h0i[s] = P.in[4][o]; } }
#pragma unroll
        for (int t = 0; t < 32; ++t) {
            const int i = 4 * (t >> 3) + (t & 3); const bool up = (t >> 2) & 1;
            const float bre = up ? R1[i] : R0[i], bim = up ? I1[i] : I0[i];
            if (SAMPLE && (t & 3) == 0) { hr = h0r[t >> 2]; hi = h0i[t >> 2]; }
            const float nr = fmaf(ar, hr, fmaf(-ai, hi, bre)), ni = fmaf(ar, hi, fmaf(ai, hr, bim));
            hr = nr; hi = ni;
            if (!LIGHT) Hp[t * S5_PITCH + lane] = pk2(nr, ni);
            if (MODE == 0 && t == 15) { c15r = nr; c15i = ni; }
            if (SAMPLE && (t & 3) == 3) { const size_t o = ((size_t)(8 * idx + (t >> 2)) * NG + g) * NST + lane; P.out[OUT_RES + o] = nr; P.out[OUT_IMS + o] = ni; }
        }
        if (!LIGHT) {
        asm volatile("s_waitcnt lgkmcnt(0)" ::: "memory");
#pragma unroll
        for (int tb = 0; tb < 2; ++tb) {
            f32x4 y = z4;
#pragma unroll
            for (int kk = 0; kk < 4; ++kk) { const bf16x8 hf = *(const LAS bf16x8*)(Hp + (16 * tb + t16) * S5_PITCH + 16 * kk + 4 * q);
                y = __builtin_amdgcn_mfma_f32_16x16x32_bf16(Cf[kk], hf, y, 0, 0, 0); }
            const int t = 16 * tb + t16;
            if (t < nvalid) { const size_t r2 = row0 + t; const float rs2 = SAMPLE ? U[t * S5_UP + 16] : rsq[32 * ck + t];
                const f32x4 uu = *(const f32x4*)(Hb + r2 * D + 16 * g + 4 * q) * rs2 * *(const f32x4*)(gn + 16 * g + 4 * q);
                f32x4 o;
#pragma unroll
                for (int e = 0; e < 4; ++e) { const float yy = y[e] + dE[e] * uu[e];
                    const float z = 1.5957691216057308f * (yy + 0.044715f * yy * yy * yy); o[e] = yy * __builtin_amdgcn_rcpf(1.0f + __expf(-z)); }
                u32x2 w; w.x = pk2(o[0], o[1]); w.y = pk2(o[2], o[3]);
                *(u32x2*)(GA + r2 * D + 16 * g + 4 * q) = w; }
        }
        asm volatile("s_waitcnt lgkmcnt(0)" ::: "memory");
        }
    }
    if (MODE == 0 && ck1 == 65) { const size_t o = ((size_t)idx * NG + g) * NST + lane; P.out[OUT_REP + o] = c15r; P.out[OUT_IMP + o] = c15i; }
}
__device__ __forceinline__ void s5_phase(KP kp, LAS unsigned char* lds, int bid, int G) {
    const Params P = *launder(kp); bid = opaque_s(bid); G = opaque_s(G);
    const int tid = opaque_v(threadIdx.x), lane = tid & 63, wave = __builtin_amdgcn_readfirstlane(tid >> 6);
    LAS unsigned char* wl = lds + S5_RSQ_BYTES + wave * S5_WLDS;
    const float* part = (const float*)(P.ws + O_PART);
    bool first = true;
    for (int pb = bid; pb < 256 || first; pb += G) {
        const int b = pb >> 6, sg = (pb >> 5) & 1, ck0 = sg ? S5_CUT : 0, ck1 = sg ? 65 : S5_CUT;
        if (pb < 256) {
            LAS float* rsq = (LAS float*)lds; const int rend = 32 * ck1 < LP ? 32 * ck1 : LP;
            for (int r = tid; r < rend; r += NTHREADS) { const f32x4* pp = (const f32x4*)(part + (size_t)(b * LP + r) * 64); float ss = 0.f;
#pragma unroll
                for (int i = 0; i < 16; ++i) { const f32x4 v = pp[i]; ss += (v[0] + v[1]) + (v[2] + v[3]); }
                rsq[r] = rsqrtf(ss * (1.0f / D) + EPS); }
        }
        __syncthreads();
        if (wave < 4) { if (pb < 256) { const int g = 4 * (pb & 31) + wave; float hr = 0.f, hi = 0.f;
            if (ck0 > 0) s5_job<2>(P, lds, wl, lane, g, b, 0, ck0, hr, hi);
            s5_job<0>(P, lds, wl, lane, g, b, ck0, ck1, hr, hi); } }
        if (wave < 4 && first) { for (int sj = bid * 4 + wave; sj < 16 * NG; sj += 4 * G) { float hr = 0.f, hi = 0.f; s5_job<1>(P, lds, wl, lane, sj % NG, sj / NG, 0, 1, hr, hi); } }
        first = false;
        __syncthreads();
    }
}


__device__ __forceinline__ float* slot_ptr(unsigned char* ws, int slot) { return (float*)(ws + (slot < 128 ? O_WIN + (size_t)slot * 262144 : O_ABF + (size_t)(slot - 128) * 262144)); }
__device__ __forceinline__ void final_phase(KP kp, int bid, int G) {
    const Params P = *launder(kp); bid = opaque_s(bid); G = opaque_s(G);
    const int tid = opaque_v(threadIdx.x), lane = tid & 63, wave = __builtin_amdgcn_readfirstlane(tid >> 6);
    const float* H = (const float*)(P.ws + O_H); const float* gf = P.in[8];
    pg8::StaticOrder SO; SO.init(MP, 2048, G, 0, SPLIT_DN);
    const bool split = !(SO.nwg % G == 0 || (long)(SO.nwg % G) * SPLIT_DN > G);
    const int ntail = split ? SO.nwg - SO.nfull : 0;
    for (int row = wave * G + bid; row < MV; row += 8 * G) {
        float* o;
        if (row < MPROMPT) { const int b = row / LP, pos = row % LP; if (pos < 16) continue; o = P.out + OUT_YP + ((size_t)b * 2048 + (pos - 16)) * D; }
        else o = P.out + OUT_YS + (size_t)(row - MPROMPT) * D;
        f32x4 v[8];
#pragma unroll
        for (int j = 0; j < 8; ++j) v[j] = *(const f32x4*)(H + (size_t)row * D + 4 * lane + 256 * j);
        const int pm = row >> 8, rl = row & 255;
        for (int tu = 0; tu < ntail; ++tu) { pg8::Unit u; SO.map(SO.nfull + tu, u);
            if (u.pm == pm) { f32x4 a = (f32x4){0.f, 0.f, 0.f, 0.f};
                for (int s2 = 0; s2 < SPLIT_DN; ++s2) a += *(const f32x4*)(slot_ptr(P.ws, tu * SPLIT_DN + s2) + (size_t)rl * 256 + 4 * lane);
#pragma unroll
                for (int j = 0; j < 8; ++j) if (j == u.pn) v[j] += a; } }
        float ss = 0.f;
#pragma unroll
        for (int j = 0; j < 8; ++j) ss += (v[j][0] * v[j][0] + v[j][1] * v[j][1]) + (v[j][2] * v[j][2] + v[j][3] * v[j][3]);
#pragma unroll
        for (int of = 1; of < 64; of <<= 1) ss += __shfl_xor(ss, of);
        const float rs = rsqrtf(ss * (1.0f / D) + EPS);
#pragma unroll
        for (int j = 0; j < 8; ++j) { const f32x4 gg = *(const f32x4*)(gf + 4 * lane + 256 * j); *(f32x4*)(o + 4 * lane + 256 * j) = v[j] * rs * gg; }
    }
}
struct EpiAll {
    int mode; float* H; float* part; bf16_t* O; bf16_t* O2; unsigned char* ws; KP kp; const LAS float* rstab;
    __device__ __forceinline__ void operator()(const f32x4 (&acc)[2][2][4][2], const pg8::Unit& u, int wr, int wc, int fr, int fq) const {
        if (u.ks >= 0) {
            float* Pp = slot_ptr(ws, u.slot) + (size_t)(wr * 64 + fr) * 256 + 32 * wc + 8 * fq;
#pragma unroll
            for (int ai = 0; ai < 2; ++ai)
#pragma unroll
                for (int m = 0; m < 4; ++m)
#pragma unroll
                    for (int bj = 0; bj < 2; ++bj) { float* p = Pp + (size_t)(ai * 128 + m * 16) * 256 + 128 * bj; *(f32x4*)p = acc[ai][bj][m][0]; *(f32x4*)(p + 4) = acc[ai][bj][m][1]; }
        }
        else if (mode == 0) { EpiG1 e{O, O2}; e(acc, u, wr, wc, fr, fq); }
        else if (mode == 1) { EpiRes<true> e{H, part, O, kp}; e(acc, u, wr, wc, fr, fq); }
        else if (mode == 2) { EpiUp e{rstab, O}; e(acc, u, wr, wc, fr, fq); }
        else if (mode == 3) { EpiRes<false> e{H, part, nullptr, kp}; e(acc, u, wr, wc, fr, fq); }
        else { EpiGlu e{H, part, O}; e(acc, u, wr, wc, fr, fq); }
    }
};
__device__ __forceinline__ void reduce_phase(KP kp, int bid, int G, int S, bool wbf) {
    const Params P = *launder(kp); bid = opaque_s(bid); G = opaque_s(G);
    const int tid = opaque_v(threadIdx.x), lane = tid & 63, wave = tid >> 6;
    float* H = (float*)(P.ws + O_H); float* part = (float*)(P.ws + O_PART); bf16_t* A = (bf16_t*)(P.ws + O_ABF);
    pg8::StaticOrder SO; SO.init(MP, 2048, G, 0, S);
    if (SO.nwg % G == 0 || (long)(SO.nwg % G) * S > G) return;
    const int ntail = SO.nwg - SO.nfull;
    constexpr int RB = 3;
    for (int w0 = wave * G + bid; w0 < ntail * 256; w0 += RB * 8 * G) {
        f32x4 a[RB], res[RB]; int tuv[RB], rv[RB], pmv[RB], pnv[RB];
#pragma unroll
        for (int k = 0; k < RB; ++k) { const int w = w0 + k * 8 * G; const bool ok = w < ntail * 256; const int ww = ok ? w : w0;
            tuv[k] = ww >> 8; rv[k] = ww & 255; pg8::Unit u; SO.map(SO.nfull + tuv[k], u); pmv[k] = u.pm; pnv[k] = ok ? u.pn : -1;
            a[k] = (f32x4){0.f, 0.f, 0.f, 0.f};
            for (int s2 = 0; s2 < S; ++s2) a[k] += *(const f32x4*)(slot_ptr(P.ws, tuv[k] * S + s2) + (size_t)rv[k] * 256 + 4 * lane);
            const size_t off = (size_t)(pmv[k] * 256 + rv[k]) * D + u.pn * 256 + 4 * lane;
            res[k] = wbf ? *(const f32x4*)(xsrc(kp, pmv[k] * 256 + rv[k]) + u.pn * 256 + 4 * lane) : *(const f32x4*)(H + off); }
#pragma unroll
        for (int k = 0; k < RB; ++k) { if (pnv[k] < 0) continue;
            const size_t row = (size_t)(pmv[k] * 256 + rv[k]);
            const f32x4 h = res[k] + a[k]; *(f32x4*)(H + row * D + pnv[k] * 256 + 4 * lane) = h;
            float ss = (h[0] * h[0] + h[1] * h[1]) + (h[2] * h[2] + h[3] * h[3]);
            ss += __shfl_xor(ss, 1); ss += __shfl_xor(ss, 2); ss += __shfl_xor(ss, 4);
            if ((lane & 7) == 0) part[row * 64 + 8 * pnv[k] + (lane >> 3)] = ss;
            if (wbf) { u32x2 o; o.x = pk2(h[0], h[1]); o.y = pk2(h[2], h[3]); *(u32x2*)(A + row * D + pnv[k] * 256 + 4 * lane) = o; } }
    }
}

#define XB_TMO      128
#define XB_XCNT(j)  (256  + 64 * (j))
#define XB_XSUB(j)  (1280 + 64 * (j))
#define XB_XGEN(j)  (2304 + 64 * (j))
#define XB_TOP      3328
#define XB_TOPGEN   3392
#define XCD_BAR_WORDS 3456
#define XB_SPIN_CAP (1u << 18)
__device__ __forceinline__ unsigned xb_ld(unsigned* p)              { return __hip_atomic_load(p, __ATOMIC_RELAXED, __HIP_MEMORY_SCOPE_AGENT); }
__device__ __forceinline__ unsigned xb_add(unsigned* p, unsigned v) { return __hip_atomic_fetch_add(p, v, __ATOMIC_RELAXED, __HIP_MEMORY_SCOPE_AGENT); }
__device__ __forceinline__ unsigned xb_xcc_id() { return (unsigned)__builtin_amdgcn_s_getreg((3 << 11) | 20) & 0xFu; }
#define XB_SPIN(cond, bar) do { unsigned _sp = 0; while (cond) { __builtin_amdgcn_s_sleep(1); \
    if ((++_sp & 255u) == 0u) { if (xb_ld(&(bar)[XB_TMO])) break; if (_sp > XB_SPIN_CAP) { atomicAdd(&(bar)[XB_TMO], 1u); break; } } } } while (0)
__device__ __forceinline__ void xcd_barrier_complete(unsigned* bar, unsigned x, unsigned G, unsigned& nloc, unsigned& nx) {
    unsigned sum, cnt, mine, sp = 0u;
    for (;;) {
        sum = 0u; cnt = 0u; mine = 0u;
#pragma unroll
        for (unsigned j = 0; j < 16; ++j) { const unsigned c = xb_ld(&bar[XB_XCNT(j)]); sum += c; cnt += (c > 0u) ? 1u : 0u; mine = (j == x) ? c : mine; }
        if (sum == G) break;
        __builtin_amdgcn_s_sleep(1);
        if ((++sp & 255u) == 0u) { if (xb_ld(&bar[XB_TMO])) break; if (sp > XB_SPIN_CAP) { atomicAdd(&bar[XB_TMO], 1u); break; } }
    }
    nloc = mine > 0u ? mine : 1u; nx = cnt > 0u ? cnt : 1u;
}
__device__ __forceinline__ void xcd_barrier(unsigned* bar, volatile LAS unsigned* st) {
    asm volatile("s_waitcnt vmcnt(0)" ::: "memory");
    __syncthreads();
    if (threadIdx.x == 0) {
        __builtin_amdgcn_s_waitcnt(0);
        const unsigned x = xb_xcc_id();
        unsigned nloc = st[0], nx = st[1];
        if (nloc == 0u) { xcd_barrier_complete(bar, x, gridDim.x, nloc, nx); st[0] = nloc; st[1] = nx; }
        const unsigned old = xb_add(&bar[XB_XSUB(x)], 1u);
        const unsigned gen = old / nloc;
        if (old + 1u == (gen + 1u) * nloc) {
            __builtin_amdgcn_fence(__ATOMIC_RELEASE, "agent");
            asm volatile("s_waitcnt vmcnt(0)" ::: "memory");
            const unsigned og = xb_add(&bar[XB_TOP], 1u);
            const unsigned tg = og / nx;
            if (og + 1u == (tg + 1u) * nx) xb_add(&bar[XB_TOPGEN], 1u);
            else XB_SPIN(xb_ld(&bar[XB_TOPGEN]) == tg, bar);
            __builtin_amdgcn_fence(__ATOMIC_ACQUIRE, "agent");
            xb_add(&bar[XB_XGEN(x)], 1u);
            asm volatile("s_waitcnt vmcnt(0)" ::: "memory");
        } else {
            XB_SPIN(xb_ld(&bar[XB_XGEN(x)]) == gen, bar);
            __builtin_amdgcn_fence(__ATOMIC_ACQUIRE, "agent");
            asm volatile("s_waitcnt vmcnt(0)" ::: "memory");
        }
    }
    __syncthreads();
}

__global__ void __launch_bounds__(NTHREADS, 2) fwd_kernel(Params Parg) {
    extern __shared__ __attribute__((aligned(16))) unsigned char shm[];
    LAS unsigned char* lds = (LAS unsigned char*)shm;
    const int bid = blockIdx.x, G = gridDim.x;
    KP kp = (KP)__builtin_amdgcn_kernarg_segment_ptr();
    const int ph_lo = kp->ph_lo, ph_hi = kp->ph_hi;
    volatile LAS unsigned* xst = (volatile LAS unsigned*)(lds + pg8::STAGE_BYTES);
    if (threadIdx.x == 0) { xst[0] = 0u; xst[1] = 0u; (void)xb_add((unsigned*)(kp->ws + O_BAR) + XB_XCNT(xb_xcc_id()), 1u); }
    __syncthreads();
    for (int ph = ph_lo; ph < ph_hi; ++ph) {
        if (ph == 0) prep_phase(kp, lds, bid, G);
        else if (ph == 2) conv_phase(kp, bid, G);
        else if (ph == 8) s5_phase(kp, lds, bid, G);
        else if (ph == 12) final_phase(kp, bid, G);
        else if (ph == 4) reduce_phase(kp, bid, G, SPLIT_G2, true);
        else if (ph == 7) reduce_phase(kp, bid, G, SPLIT_DN, false);
        else {
            size_t oa, ob, oo, oo2 = 0; int N, K, mode, S = 1;
            if (ph == 1) { oa = O_ABF; ob = O_WIN; N = 6144; K = 2048; mode = 0; oo = O_V; oo2 = O_BG; }
            else if (ph == 3) { oa = O_BG; ob = O_WOUT; N = 2048; K = 2048; mode = 1; oo = O_ABF; S = SPLIT_G2; }
            else if (ph == 5) { oa = O_ABF; ob = O_WUP0; N = 8192; K = 2048; mode = 2; oo = O_ACT; }
            else if (ph == 6) { oa = O_ACT; ob = O_WDN0; N = 2048; K = 8192; mode = 3; oo = 0; S = SPLIT_DN; }
            else if (ph == 9) { oa = O_ABF; ob = O_WGLU; N = 4096; K = 2048; mode = 4; oo = O_ABF2; }
            else if (ph == 10) { oa = O_ABF2; ob = O_WUP1; N = 8192; K = 2048; mode = 2; oo = O_ACT; }
            else { oa = O_ACT; ob = O_WDN1; N = 2048; K = 8192; mode = 3; oo = 0; S = SPLIT_DN; }
            unsigned char* ws = launder(kp)->ws;
            if ((N / 256) * (MP / 256) % G == 0 || (long)((N / 256) * (MP / 256) % G) * S > G) S = 1;
            pg8::Gemm g{(const bf16_t*)(ws + oa), (const bf16_t*)(ws + ob), MP, N, K}; pg8::StaticOrder S_; S_.init(MP, N, G, bid, S);
            LAS float* rstab = (LAS float*)(lds + pg8::STAGE_BYTES + 16);
            if (mode == 2) {
                const int t = opaque_v(threadIdx.x), row = t >> 1, hf = t & 1; const float* part = (const float*)(ws + O_PART);
                pg8::Unit u;
                for (int i = 0; i < RS_UNITS && S_.next(i, u); ++i) { const f32x4* pp = (const f32x4*)(part + (size_t)(u.pm * 256 + row) * 64 + 32 * hf); float ss = 0.f;
#pragma unroll
                    for (int k = 0; k < 8; ++k) { const f32x4 v = pp[k]; ss += (v[0] + v[1]) + (v[2] + v[3]); }
                    ss += __shfl_xor(ss, 1);
                    if (hf == 0) rstab[i * 256 + row] = rsqrtf(ss * (1.0f / D) + EPS); }
                __syncthreads();
            }
            EpiAll E{mode, (float*)(ws + O_H), (float*)(ws + O_PART), (bf16_t*)(ws + oo), (bf16_t*)(ws + oo2), ws, kp, rstab};
            pg8::gemm_phase(lds, g, S_, E);
            if (ph == 1 || ph == 5 || ph == 9 || ph == 10) { const int r = ((N / 256) * (MP / 256)) % G;
                const int j0 = ph == 1 ? 6144 : (ph == 5 ? 16384 : (ph == 9 ? 28672 : 36864)), j1 = ph == 1 ? 16384 : (ph == 5 ? 28672 : (ph == 9 ? 36864 : 45056));
                if (r == 0) filler_phase(kp, bid, G, 0, j0, j1); else if (bid >= r) filler_phase(kp, bid, G, r, j0, j1); }
        }
        if (ph + 1 < ph_hi) {
            if (ph_hi > 1000) { __syncthreads(); cg::this_grid().sync(); }
            else xcd_barrier((unsigned*)(launder(kp)->ws + O_BAR), xst);
        }
    }
}

constexpr int LDS_BYTES = pg8::STAGE_BYTES + 16 + RS_UNITS * 256 * 4;
extern "C" void kernel_launch(void* const* d_in, const int* in_sizes, int n_in, void* d_out, int out_size, void* d_ws, size_t ws_size, hipStream_t stream) {
    static int grid = 0;
    if (grid == 0) {
        if (n_in != 24 || ws_size < O_END) { fprintf(stderr, "kernel_launch: unexpected n_in %d or ws_size %zu (< %zu)\n", n_in, ws_size, (size_t)O_END); grid = -1; return; }
        int dev = 0, cus = 0, per_cu = 0;
        hipGetDevice(&dev); hipDeviceGetAttribute(&cus, hipDeviceAttributeMultiprocessorCount, dev);
        hipFuncSetAttribute((const void*)fwd_kernel, hipFuncAttributeMaxDynamicSharedMemorySize, LDS_BYTES);
        hipOccupancyMaxActiveBlocksPerMultiprocessor(&per_cu, (const void*)fwd_kernel, NTHREADS, LDS_BYTES);
        if (per_cu < 1) per_cu = 1;
        (void)hipGetLastError();
        grid = cus * 1;
        (void)per_cu;
    }
    if (grid < 0) return;
    if (hipMemsetAsync((char*)d_ws + O_BAR, 0, 16384, stream) != hipSuccess) return;
    Params p{};
    for (int i = 0; i < 24; ++i) p.in[i] = (const float*)d_in[i];
    p.out = (float*)d_out; p.ws = (unsigned char*)d_ws;
#if N_LAUNCH_MODE == 1
    p.ph_lo = 0; p.ph_hi = NPHASES;
    void* args[] = {&p};
    hipError_t e = hipLaunchCooperativeKernel((const void*)fwd_kernel, dim3(grid), dim3(NTHREADS), args, LDS_BYTES, stream);
    if (e != hipSuccess) fprintf(stderr, "cooperative launch failed: %s (grid %d)\n", hipGetErrorString(e), grid);
#else
    for (int ph = 0; ph < NPHASES; ++ph) { if (!((DBG_LAUNCH_MASK >> ph) & 1)) continue; p.ph_lo = ph; p.ph_hi = ph + 1; hipLaunchKernelGGL(fwd_kernel, dim3(grid), dim3(NTHREADS), LDS_BYTES, stream, p); }
#endif
}
```

```cpp
#include <hip/hip_runtime.h>
#include <hip/hip_cooperative_groups.h>
#include <cstdio>
namespace cg = cooperative_groups;

#ifndef PHMASK
#define PHMASK 2047
#endif
#ifndef DBG_LAUNCH_MASK
#define DBG_LAUNCH_MASK 0x1FFF
#endif
#ifndef DBL_PHASE
#define DBL_PHASE -1
#define DBL_REPS 0
#endif
#ifndef N_LAUNCH_MODE
#define N_LAUNCH_MODE 1
#endif

#define LAS __attribute__((address_space(3)))
typedef unsigned short bf16_t;
typedef short bf16x8 __attribute__((ext_vector_type(8)));
typedef float f32x4 __attribute__((ext_vector_type(4)));
typedef float f32x2 __attribute__((ext_vector_type(2)));
typedef float f32x16 __attribute__((ext_vector_type(16)));
typedef unsigned u32x4 __attribute__((ext_vector_type(4)));
typedef unsigned u32x2 __attribute__((ext_vector_type(2)));

constexpr int D = 2048, FF = 8192, LP = 2064, NB = 4, MPROMPT = NB * LP  , NSEQ = 128, MV = MPROMPT + NSEQ * 4  , MP = 8960;
constexpr int NG = 128, NST = 64;
constexpr float EPS = 1e-6f;
constexpr int NTHREADS = 512, NPHASES = 13;
constexpr int RS_UNITS = 8;
constexpr int SPLIT_G2 = 4, SPLIT_DN = 8;

constexpr size_t O_WIN = 0;
constexpr size_t O_WOUT = O_WIN + (size_t)6144 * 2048 * 2;
constexpr size_t O_WUP0 = O_WOUT + (size_t)2048 * 2048 * 2;
constexpr size_t O_WDN0 = O_WUP0 + (size_t)8192 * 2048 * 2;
constexpr size_t O_WGLU = O_WDN0 + (size_t)8192 * 2048 * 2;
constexpr size_t O_WUP1 = O_WGLU + (size_t)4096 * 2048 * 2;
constexpr size_t O_WDN1 = O_WUP1 + (size_t)8192 * 2048 * 2;
constexpr size_t O_H = O_WDN1 + (size_t)8192 * 2048 * 2;
constexpr size_t O_ABF = O_H + (size_t)MP * D * 4;
constexpr size_t O_ACT = O_ABF + (size_t)MP * D * 2;
constexpr size_t O_PART = O_ACT + (size_t)MP * FF * 2;
constexpr size_t O_ABAR = O_PART + (size_t)MP * 64 * 4;
constexpr size_t O_BFR = O_ABAR + (size_t)NG * NST * 8;
constexpr size_t O_CFR = O_BFR + (size_t)NG * 4 * 64 * 16;
constexpr size_t O_BAR = O_CFR + (size_t)NG * 4 * 64 * 16;
constexpr size_t O_END = O_BAR + 16384;
constexpr size_t O_BG = O_ACT;
constexpr size_t O_V = O_ACT + (size_t)MP * D * 2;
constexpr size_t O_ABF2 = O_WUP0;

constexpr size_t OUT_YP = 0, OUT_YS = 16777216, OUT_CONVP = 17825792, OUT_REP = 17842176, OUT_IMP = 17874944, OUT_CONVS = 17907712, OUT_RES = 18432000, OUT_IMS = 19480576;

struct Params { const float* in[24]; float* out; unsigned char* ws; int ph_lo, ph_hi; };
#if defined(__HIP_DEVICE_COMPILE__)
typedef const __attribute__((address_space(4))) Params* KP;
#else
typedef const Params* KP;
#endif
__device__ __forceinline__ KP launder(KP p) { asm volatile("" : "+s"(p)); return p; }
__device__ __forceinline__ int opaque_v(int v) { asm volatile("" : "+v"(v)); return v; }
__device__ __forceinline__ int opaque_s(int v) { asm volatile("" : "+s"(v)); return v; }

typedef __bf16 bf16x2_t __attribute__((ext_vector_type(2)));
__device__ __forceinline__ unsigned pk2(float lo, float hi) { f32x2 v = {lo, hi}; bf16x2_t b = __builtin_convertvector(v, bf16x2_t); return __builtin_bit_cast(unsigned, b); }
__device__ __forceinline__ float bf_lo(unsigned w) { return __uint_as_float(w << 16); }
__device__ __forceinline__ float bf_hi(unsigned w) { return __uint_as_float(w & 0xffff0000u); }

namespace pg8 {
constexpr int BM = 256, BK = 64, HALF = 128, HTB = HALF * BK * 2, STAGE_BYTES = 8 * HTB, NXCD = 8, WGM = 8;
__device__ __forceinline__ int lds_byte(int r, int c) { const int st = (r >> 4) * 2 + (c >> 5), rr = r & 15, cc = c & 31, ob = rr * 64 + cc * 2; return st * 1024 + (ob ^ (((ob >> 9) & 1) << 5)); }
__device__ __forceinline__ void stage_rc(int b, int& R, int& C) { const int st = b / 1024, sb = b % 1024, swz = sb ^ (((sb >> 9) & 1) << 5); R = (st >> 1) * 16 + swz / 64; C = (st & 1) * 32 + (swz % 64) / 2; }
__device__ __forceinline__ int perm32(int rho) { const int n = rho >> 4, i = rho & 15; return 8 * (i >> 2) + 4 * n + (i & 3); }
struct Unit { int pm, pn, ks, slot; };
struct Gemm { const bf16_t* A; const bf16_t* Bt; int M, N, K; };
struct StaticOrder {
    int nM, nN, nwg, G, c, S, nfull;
    __device__ void init(int M, int N, int G_, int c_, int S_) { nM = M / BM; nN = N / BM; nwg = nM * nN; G = G_; c = c_; S = S_; nfull = (S_ > 1) ? (nwg / G_) * G_ : nwg; }
    __device__ void map(int wgid, Unit& u) const {
        { const int q = nwg / NXCD, r = nwg % NXCD, xcd = wgid % NXCD, off = wgid / NXCD; wgid = (xcd < r ? xcd * (q + 1) : r * (q + 1) + (xcd - r) * q) + off; }
        const int nig = WGM * nN, gid = wgid / nig, fm = gid * WGM, gsz = (nM - fm) < WGM ? (nM - fm) : WGM;
        u.pm = fm + ((wgid % nig) % gsz); u.pn = (wgid % nig) / gsz;
    }
    __device__ bool next(int i, Unit& u) const {
        const long L = (long)i * G + c;
        if (L < nfull) { map((int)L, u); u.ks = -1; u.slot = i; return true; }
        const long j = L - nfull; if (j >= (long)(nwg - nfull) * S) return false;
        map(nfull + (int)j / S, u); u.ks = (int)j % S; u.slot = (int)j; return true;
    }
};

template <class Epi>
__device__ __forceinline__ void gemm_phase(LAS unsigned char* lds, const Gemm g, const StaticOrder& S, const Epi& E) {
    const int tid = opaque_v(threadIdx.x), wid = __builtin_amdgcn_readfirstlane(tid >> 6), lane = tid & 63, wr = wid >> 2, wc = wid & 3, fr = lane & 15, fq = lane >> 4;
    const int K = g.K, KS = K / S.S;
    unsigned voffA[2], voffB[2];
#pragma unroll
    for (int i = 0; i < 2; ++i) { int R, C; stage_rc(tid * 16 + i * 8192, R, C); const int Rb = (R & ~31) + perm32(R & 31);
        voffA[i] = (unsigned)(R * K + C) * 2u; voffB[i] = (unsigned)(Rb * K + C) * 2u; }
    const size_t kstep = (size_t)(BK * 2);
    const size_t hstep = (size_t)HALF * K * 2;
    const size_t tstep = 2 * hstep;
    const unsigned ldsw = (unsigned)wid * 1024u;
    const int aoff = lds_byte(wr * 64 + fr, fq * 8), boff = lds_byte(wc * 32 + fr, fq * 8);
#define PG8_SA(b, h) (((b) * 2 + (h)) * HTB)
#define PG8_SB(b, h) ((4 + (b) * 2 + (h)) * HTB)
#define PG8_STAGE(bufoff, gbase, voff) do { _Pragma("unroll") for (int _i = 0; _i < 2; ++_i) \
        __builtin_amdgcn_global_load_lds((const unsigned*)((const char*)(gbase) + (voff)[_i]), (LAS unsigned*)(lds + (bufoff) + ldsw + _i * 8192), 16, 0, 0); } while (0)
#define PG8_LDA(dst, b, h) do { _Pragma("unroll") for (int m = 0; m < 4; ++m) _Pragma("unroll") for (int k = 0; k < 2; ++k) dst[m][k] = *(const LAS bf16x8*)(lds + PG8_SA(b, h) + aoff + m * 2048 + k * 1024); } while (0)
#define PG8_LDB(dst, b, h) do { _Pragma("unroll") for (int n = 0; n < 2; ++n) _Pragma("unroll") for (int k = 0; k < 2; ++k) dst[n][k] = *(const LAS bf16x8*)(lds + PG8_SB(b, h) + boff + n * 2048 + k * 1024); } while (0)
#define PG8_MMA(ai, bj, At, Bt) do { __builtin_amdgcn_s_setprio(1); _Pragma("unroll") for (int m = 0; m < 4; ++m) _Pragma("unroll") for (int n = 0; n < 2; ++n) _Pragma("unroll") for (int k = 0; k < 2; ++k) \
        acc[ai][bj][m][n] = __builtin_amdgcn_mfma_f32_16x16x32_bf16(Bt[n][k], At[m][k], acc[ai][bj][m][n], 0, 0, 0); __builtin_amdgcn_s_setprio(0); } while (0)
#define PG8_WAIT_V(n) asm volatile("s_waitcnt vmcnt(" #n ")" ::: "memory")
#define PG8_WAIT_L(n) asm volatile("s_waitcnt lgkmcnt(" #n ")" ::: "memory")
#define PG8_BAR __builtin_amdgcn_s_barrier()
#define PG8_SCHED __builtin_amdgcn_sched_barrier(0)
    Unit cur, nxt; int ui = 0;
    if (!S.next(0, cur)) return;
    f32x4 acc[2][2][4][2];
#pragma unroll
    for (int a = 0; a < 2; ++a)
#pragma unroll
        for (int b = 0; b < 2; ++b)
#pragma unroll
            for (int m = 0; m < 4; ++m)
#pragma unroll
                for (int n = 0; n < 2; ++n) acc[a][b][m][n] = (f32x4){0.f, 0.f, 0.f, 0.f};
    bf16x8 At[4][2], B0[2][2], B1[2][2];
    size_t koff = cur.ks < 0 ? 0 : (size_t)cur.ks * KS * 2; int nt = (cur.ks < 0 ? K : KS) / BK;
    const char* cA = (const char*)g.A + (size_t)cur.pm * tstep + koff; const char* cB = (const char*)g.Bt + (size_t)cur.pn * tstep + koff;
    PG8_STAGE(PG8_SB(0, 0), cB, voffB); PG8_STAGE(PG8_SA(0, 0), cA, voffA); PG8_STAGE(PG8_SB(0, 1), cB + hstep, voffB); PG8_STAGE(PG8_SA(0, 1), cA + hstep, voffA);
    if (wr == 1) PG8_BAR;
    PG8_WAIT_V(4); PG8_BAR;
    PG8_STAGE(PG8_SB(1, 0), cB + kstep, voffB); PG8_STAGE(PG8_SA(1, 0), cA + kstep, voffA); PG8_STAGE(PG8_SB(1, 1), cB + hstep + kstep, voffB);
    PG8_WAIT_V(6); PG8_BAR;
    for (;;) {
        const bool has_next = S.next(ui + 1, nxt);
        const size_t nkoff = (has_next && nxt.ks >= 0) ? (size_t)nxt.ks * KS * 2 : 0;
        const char* nA = has_next ? (const char*)g.A + (size_t)nxt.pm * tstep + nkoff : cA; const char* nB = has_next ? (const char*)g.Bt + (size_t)nxt.pn * tstep + nkoff : cB;
        for (int t = 0; t < nt; t += 2) {
            const bool last = (t == nt - 2);
            const char* a1 = cA + (size_t)(t + 1) * kstep;
            const char* a2 = last ? nA : cA + (size_t)(t + 2) * kstep; const char* b2 = last ? nB : cB + (size_t)(t + 2) * kstep;
            const char* a3 = a2 + kstep; const char* b3 = b2 + kstep;
            PG8_LDB(B0, 0, 0); PG8_SCHED; PG8_LDA(At, 0, 0); PG8_STAGE(PG8_SA(1, 1), a1 + hstep, voffA);
            PG8_WAIT_L(8); PG8_BAR; PG8_WAIT_L(0); PG8_MMA(0, 0, At, B0); PG8_BAR; PG8_SCHED;
            PG8_LDB(B1, 0, 1); PG8_STAGE(PG8_SB(0, 0), b2, voffB);
            PG8_BAR; PG8_WAIT_L(0); PG8_MMA(0, 1, At, B1); PG8_BAR;
            PG8_LDA(At, 0, 1); PG8_STAGE(PG8_SA(0, 0), a2, voffA);
            PG8_BAR; PG8_WAIT_L(0); PG8_MMA(1, 0, At, B0); PG8_BAR; PG8_SCHED;
            PG8_STAGE(PG8_SB(0, 1), b2 + hstep, voffB);
            PG8_WAIT_V(6); PG8_BAR; PG8_MMA(1, 1, At, B1); PG8_BAR;
            PG8_LDB(B0, 1, 0); PG8_SCHED; PG8_LDA(At, 1, 0); PG8_STAGE(PG8_SA(0, 1), a2 + hstep, voffA);
            PG8_WAIT_L(8); PG8_BAR; PG8_WAIT_L(0); PG8_MMA(0, 0, At, B0); PG8_BAR; PG8_SCHED;
            PG8_LDB(B1, 1, 1); PG8_STAGE(PG8_SB(1, 0), b3, voffB);
            PG8_BAR; PG8_WAIT_L(0); PG8_MMA(0, 1, At, B1); PG8_BAR;
            PG8_LDA(At, 1, 1); PG8_STAGE(PG8_SA(1, 0), a3, voffA);
            PG8_BAR; PG8_WAIT_L(0); PG8_MMA(1, 0, At, B0); PG8_BAR; PG8_SCHED;
            PG8_STAGE(PG8_SB(1, 1), b3 + hstep, voffB);
            PG8_WAIT_V(6); PG8_BAR; PG8_MMA(1, 1, At, B1); PG8_BAR;
        }
        E(acc, cur, wr, wc, fr, fq);
        if (!has_next) break;
#pragma unroll
        for (int a = 0; a < 2; ++a)
#pragma unroll
            for (int b = 0; b < 2; ++b)
#pragma unroll
                for (int m = 0; m < 4; ++m)
#pragma unroll
                    for (int n = 0; n < 2; ++n) acc[a][b][m][n] = (f32x4){0.f, 0.f, 0.f, 0.f};
        cur = nxt; cA = nA; cB = nB; ++ui; nt = (cur.ks < 0 ? K : KS) / BK;
    }
    PG8_WAIT_V(0);
    if (wr == 0) PG8_BAR;
    PG8_BAR;
#undef PG8_SA
#undef PG8_SB
#undef PG8_STAGE
#undef PG8_LDA
#undef PG8_LDB
#undef PG8_MMA
#undef PG8_WAIT_V
#undef PG8_WAIT_L
#undef PG8_BAR
#undef PG8_SCHED
}
}

__device__ __forceinline__ f32x4 up4lo(const u32x4 w) { return (f32x4){bf_lo(w.x), bf_hi(w.x), bf_lo(w.y), bf_hi(w.y)}; }
__device__ __forceinline__ f32x4 up4hi(const u32x4 w) { return (f32x4){bf_lo(w.z), bf_hi(w.z), bf_lo(w.w), bf_hi(w.w)}; }
__device__ __forceinline__ f32x4 up4(const u32x2 w) { return (f32x4){bf_lo(w.x), bf_hi(w.x), bf_lo(w.y), bf_hi(w.y)}; }
__device__ __forceinline__ u32x4 pack8(const f32x4 a, const f32x4 b) { u32x4 w; w.x = pk2(a[0], a[1]); w.y = pk2(a[2], a[3]); w.z = pk2(b[0], b[1]); w.w = pk2(b[2], b[3]); return w; }

struct EpiG1 {
    bf16_t* V; bf16_t* BG;
    __device__ __forceinline__ void operator()(const f32x4 (&acc)[2][2][4][2], const pg8::Unit& u, int wr, int wc, int fr, int fq) const {
        const int row0 = u.pm * 256 + wr * 64 + fr;
        if (u.pn < 16) {
            const int ch0 = 128 * u.pn + 32 * wc + 8 * fq;
#pragma unroll
            for (int ai = 0; ai < 2; ++ai)
#pragma unroll
                for (int m = 0; m < 4; ++m) { const size_t r = row0 + ai * 128 + m * 16;
                    *(u32x4*)(V + r * D + ch0) = pack8(acc[ai][0][m][0] * acc[ai][1][m][0], acc[ai][0][m][1] * acc[ai][1][m][1]); }
        } else {
            const int c0 = 256 * (u.pn - 16) + 32 * wc + 8 * fq;
#pragma unroll
            for (int ai = 0; ai < 2; ++ai)
#pragma unroll
                for (int m = 0; m < 4; ++m) { const size_t r = row0 + ai * 128 + m * 16;
#pragma unroll
                    for (int bj = 0; bj < 2; ++bj) *(u32x4*)(BG + r * D + c0 + 128 * bj) = pack8(acc[ai][bj][m][0], acc[ai][bj][m][1]); }
        }
    }
};
__device__ __forceinline__ const float* xsrc(KP kp, int row) {
    if (row < MPROMPT) { const int b = row / LP, pos = row - b * LP; return pos < 16 ? kp->in[5] + (size_t)pos * D : kp->in[0] + ((size_t)b * 2048 + (pos - 16)) * D; }
    if (row < MV) return kp->in[1] + (size_t)(row - MPROMPT) * D;
    return kp->in[5];
}
template <bool WBF> struct EpiRes {
    bf16_t* HB; float* part; bf16_t* O; KP kp;
    __device__ __forceinline__ void operator()(const f32x4 (&acc)[2][2][4][2], const pg8::Unit& u, int wr, int wc, int fr, int fq) const {
        const int row0 = u.pm * 256 + wr * 64 + fr, c0 = 256 * u.pn + 32 * wc + 8 * fq;
#pragma unroll
        for (int ai = 0; ai < 2; ++ai) {
            f32x4 rv[4][2][2];
#pragma unroll
            for (int m = 0; m < 4; ++m) { const size_t r = row0 + ai * 128 + m * 16;
                if (WBF) { const float* rp = xsrc(kp, (int)r) + c0;
#pragma unroll
                    for (int bj = 0; bj < 2; ++bj) { rv[m][bj][0] = *(const f32x4*)(rp + 128 * bj); rv[m][bj][1] = *(const f32x4*)(rp + 128 * bj + 4); } }
                else {
#pragma unroll
                    for (int bj = 0; bj < 2; ++bj) { const u32x4 w = *(const u32x4*)(HB + r * D + c0 + 128 * bj); rv[m][bj][0] = up4lo(w); rv[m][bj][1] = up4hi(w); } } }
#pragma unroll
            for (int m = 0; m < 4; ++m) { const size_t r = row0 + ai * 128 + m * 16;
#pragma unroll
                for (int bj = 0; bj < 2; ++bj) {
                    const f32x4 h0 = rv[m][bj][0] + acc[ai][bj][m][0], h1 = rv[m][bj][1] + acc[ai][bj][m][1];
                    *(u32x4*)(HB + r * D + c0 + 128 * bj) = pack8(h0, h1);
                    float ss = (h0[0] * h0[0] + h0[1] * h0[1]) + (h0[2] * h0[2] + h0[3] * h0[3]) + (h1[0] * h1[0] + h1[1] * h1[1]) + (h1[2] * h1[2] + h1[3] * h1[3]);
                    ss += __shfl_xor(ss, 16); ss += __shfl_xor(ss, 32);
                    if (fq == 0) part[r * 64 + 8 * u.pn + 4 * bj + wc] = ss; } }
            asm volatile("" ::: "memory"); }
    }
};
struct EpiUp {
    const LAS float* rstab; bf16_t* O;
    __device__ __forceinline__ void operator()(const f32x4 (&acc)[2][2][4][2], const pg8::Unit& u, int wr, int wc, int fr, int fq) const {
        const int row0 = u.pm * 256 + wr * 64 + fr, c0 = 256 * u.pn + 32 * wc + 8 * fq;
        const LAS float* rt = rstab + u.slot * 256 + wr * 64 + fr;
#pragma unroll
        for (int ai = 0; ai < 2; ++ai) {
#pragma unroll
            for (int m = 0; m < 4; ++m) { const size_t r = row0 + ai * 128 + m * 16; const float rs = rt[ai * 128 + m * 16];
#pragma unroll
                for (int bj = 0; bj < 2; ++bj) { f32x4 a0 = acc[ai][bj][m][0] * rs, a1 = acc[ai][bj][m][1] * rs;
#pragma unroll
                    for (int e = 0; e < 4; ++e) { a0[e] = fmaxf(a0[e], 0.f); a0[e] *= a0[e]; a1[e] = fmaxf(a1[e], 0.f); a1[e] *= a1[e]; }
                    *(u32x4*)(O + r * FF + c0 + 128 * bj) = pack8(a0, a1); } } }
    }
};
struct EpiGlu {
    bf16_t* HB; float* part; bf16_t* O;
    __device__ __forceinline__ void operator()(const f32x4 (&acc)[2][2][4][2], const pg8::Unit& u, int wr, int wc, int fr, int fq) const {
        const int row0 = u.pm * 256 + wr * 64 + fr, ch0 = 128 * u.pn + 32 * wc + 8 * fq;
#pragma unroll
        for (int ai = 0; ai < 2; ++ai) {
            u32x4 rv[4];
#pragma unroll
            for (int m = 0; m < 4; ++m) rv[m] = *(const u32x4*)(HB + (size_t)(row0 + ai * 128 + m * 16) * D + ch0);
#pragma unroll
            for (int m = 0; m < 4; ++m) { const size_t r = row0 + ai * 128 + m * 16;
                f32x4 h0 = up4lo(rv[m]), h1 = up4hi(rv[m]);
#pragma unroll
                for (int e = 0; e < 4; ++e) { h0[e] += acc[ai][0][m][0][e] * __builtin_amdgcn_rcpf(1.0f + __expf(-acc[ai][1][m][0][e])); h1[e] += acc[ai][0][m][1][e] * __builtin_amdgcn_rcpf(1.0f + __expf(-acc[ai][1][m][1][e])); }
                *(u32x4*)(HB + r * D + ch0) = pack8(h0, h1);
                float ss = (h0[0] * h0[0] + h0[1] * h0[1]) + (h0[2] * h0[2] + h0[3] * h0[3]) + (h1[0] * h1[0] + h1[1] * h1[1]) + (h1[2] * h1[2] + h1[3] * h1[3]);
                ss += __shfl_xor(ss, 16); ss += __shfl_xor(ss, 32);
                if (fq == 0) part[r * 64 + 4 * u.pn + wc] = ss; }
            asm volatile("" ::: "memory"); }
    }
};

__device__ __forceinline__ void job_info(KP P_, int j, const float*& src, int& Nsrc, const float*& gain, bf16_t*& dst, int& K, int& k0, int& n0) {
    int mode, ndt; const float* src2 = nullptr; unsigned char* ws = P_->ws;
    if (j < 6144) { src = P_->in[9]; Nsrc = 6144; gain = P_->in[6]; dst = (bf16_t*)(ws + O_WIN); K = 2048; ndt = 96; mode = 1; }
    else if (j < 8192) { j -= 6144; src = P_->in[11]; Nsrc = 2048; gain = nullptr; dst = (bf16_t*)(ws + O_WOUT); K = 2048; ndt = 32; mode = 0; }
    else if (j < 16384) { j -= 8192; src = P_->in[22]; Nsrc = 8192; gain = P_->in[7]; dst = (bf16_t*)(ws + O_WUP0); K = 2048; ndt = 128; mode = 0; }
    else if (j < 24576) { j -= 16384; src = P_->in[23]; Nsrc = 2048; gain = nullptr; dst = (bf16_t*)(ws + O_WDN0); K = 8192; ndt = 32; mode = 0; }
    else if (j < 28672) { j -= 24576; src = P_->in[20]; src2 = P_->in[21]; Nsrc = 2048; gain = nullptr; dst = (bf16_t*)(ws + O_WGLU); K = 2048; ndt = 64; mode = 2; }
    else if (j < 36864) { j -= 28672; src = P_->in[22] + (size_t)2048 * 8192; Nsrc = 8192; gain = P_->in[7] + 2048; dst = (bf16_t*)(ws + O_WUP1); K = 2048; ndt = 128; mode = 0; }
    else { j -= 36864; src = P_->in[23] + (size_t)8192 * 2048; Nsrc = 2048; gain = nullptr; dst = (bf16_t*)(ws + O_WDN1); K = 8192; ndt = 32; mode = 0; }
    const int nb = j % ndt, kc = j / ndt; k0 = kc * 32; n0 = nb * 64;
    int col = n0;
    if (mode == 1) { if (n0 < 4096) { const int pn = n0 >> 8, bj = (n0 >> 7) & 1, j0 = n0 & 127; col = (bj ? 4096 : 2048) + 128 * pn + j0; } else col = n0 - 4096; }
    if (mode == 2) { const int pn = n0 >> 8, bj = (n0 >> 7) & 1, j0 = n0 & 127; col = 128 * pn + j0; if (bj) src = src2; }
    src += col;
}
constexpr int NJOBS = 45056, NJOBS_L0 = 24576, NJOBS_F1 = 31744, NJOBS_F2 = 38912;
__device__ __forceinline__ void convert_jobs(KP kp, int j0, int j1, int widx, int nw, int lane) {
    for (int j = j0 + widx; j < j1; j += nw) {
        const float* src; int Nsrc; const float* gain; bf16_t* dst; int K, k0, n0;
        job_info(kp, j, src, Nsrc, gain, dst, K, k0, n0);
        const float* sp = src + (size_t)k0 * Nsrc + lane;
        float v[32];
#pragma unroll
        for (int i = 0; i < 32; ++i) v[i] = sp[(size_t)i * Nsrc];
        if (gain) {
#pragma unroll
            for (int i = 0; i < 32; ++i) v[i] *= gain[k0 + i]; }
        bf16_t* dp = dst + (size_t)(n0 + lane) * K + k0;
#pragma unroll
        for (int o = 0; o < 4; ++o) { u32x4 w; w.x = pk2(v[8 * o], v[8 * o + 1]); w.y = pk2(v[8 * o + 2], v[8 * o + 3]); w.z = pk2(v[8 * o + 4], v[8 * o + 5]); w.w = pk2(v[8 * o + 6], v[8 * o + 7]);
            *(u32x4*)(dp + 8 * o) = w; }
    }
}
__device__ __forceinline__ void filler_phase(KP kp, int bid, int G, int r, int j0, int j1) {
    kp = launder(kp); bid = opaque_s(bid); G = opaque_s(G);
    const int tid = opaque_v(threadIdx.x), lane = tid & 63, wv = __builtin_amdgcn_readfirstlane(tid >> 6);
    convert_jobs(kp, j0, j1, (bid - r) * 8 + wv, (G - r) * 8, lane);
}
__device__ __forceinline__ void prep_phase(KP kp, LAS unsigned char* lds, int bid, int G) {
    kp = launder(kp); bid = opaque_s(bid); G = opaque_s(G);
    const int tid = opaque_v(threadIdx.x), lane = tid & 63, wave = tid >> 6;
    convert_jobs(kp, 0, 6144, bid * 8 + __builtin_amdgcn_readfirstlane(wave), 8 * G, lane);
    if (false) {
        const int wv = __builtin_amdgcn_readfirstlane(wave);
        for (int j = bid * 8 + wv; j < NJOBS; j += 8 * G) {
            const float* src; int Nsrc; const float* gain; bf16_t* dst; int K, k0, n0;
            job_info(kp, j, src, Nsrc, gain, dst, K, k0, n0);
            const float* sp = src + (size_t)k0 * Nsrc + lane;
            float v[32];
#pragma unroll
            for (int i = 0; i < 32; ++i) v[i] = sp[(size_t)i * Nsrc];
            if (gain) {
#pragma unroll
                for (int i = 0; i < 32; ++i) v[i] *= gain[k0 + i]; }
            bf16_t* dp = dst + (size_t)(n0 + lane) * K + k0;
#pragma unroll
            for (int o = 0; o < 4; ++o) { u32x4 w; w.x = pk2(v[8 * o], v[8 * o + 1]); w.y = pk2(v[8 * o + 2], v[8 * o + 3]); w.z = pk2(v[8 * o + 4], v[8 * o + 5]); w.w = pk2(v[8 * o + 6], v[8 * o + 7]);
                *(u32x4*)(dp + 8 * o) = w; }
        }
    }
    {   const Params P = *launder(kp);
        float* H = (float*)(P.ws + O_H); bf16_t* A = (bf16_t*)(P.ws + O_ABF);
        for (int row = wave * G + bid; row < MP; row += 8 * G) {
            const float* xs = nullptr;
            if (row < MPROMPT) { const int b = row / LP, pos = row % LP; xs = pos < 16 ? P.in[5] + (size_t)pos * D : P.in[0] + ((size_t)b * 2048 + (pos - 16)) * D; }
            else if (row < MV) xs = P.in[1] + (size_t)(row - MPROMPT) * D;
            f32x4 v[8]; float ss = 0.f;
#pragma unroll
            for (int j = 0; j < 8; ++j) { v[j] = xs ? *(const f32x4*)(xs + 4 * lane + 256 * j) : (f32x4){0.f, 0.f, 0.f, 0.f}; ss += (v[j][0] * v[j][0] + v[j][1] * v[j][1]) + (v[j][2] * v[j][2] + v[j][3] * v[j][3]); }
#pragma unroll
            for (int o = 1; o < 64; o <<= 1) ss += __shfl_xor(ss, o);
            const float rs = rsqrtf(ss * (1.0f / D) + EPS);
#pragma unroll
            for (int j = 0; j < 8; ++j) {
                u32x2 w; w.x = pk2(v[j][0] * rs, v[j][1] * rs); w.y = pk2(v[j][2] * rs, v[j][3] * rs); *(u32x2*)(A + (size_t)row * D + 4 * lane + 256 * j) = w; }
        }
    }
    {   const Params P = *launder(kp);
        const int gt = bid * NTHREADS + tid, NT = G * NTHREADS;
        for (int i = gt; i < NG * NST; i += NT) { const int g = i >> 6, p = i & 63;
            const float dt = expf(P.in[14][g]), lr = P.in[12][i], li = P.in[13][i];
            const float mag = expf(lr * dt), are = mag * cosf(li * dt), aim = mag * sinf(li * dt);
            ((f32x2*)(P.ws + O_ABAR))[i] = (f32x2){are, aim};
            const float nr = are - 1.0f, ni = aim, den = lr * lr + li * li, qre = (nr * lr + ni * li) / den, qim = (ni * lr - nr * li) / den;
            const float* bre = P.in[15] + (size_t)i * 16; const float* bim = P.in[16] + (size_t)i * 16;
            bf16_t* BF = (bf16_t*)(P.ws + O_BFR);
#pragma unroll
            for (int ch = 0; ch < 2; ++ch) { f32x4 r0 = *(const f32x4*)(bre + 8 * ch), r1 = *(const f32x4*)(bre + 8 * ch + 4), i0 = *(const f32x4*)(bim + 8 * ch), i1 = *(const f32x4*)(bim + 8 * ch + 4);
                const f32x4 o0 = r0 * qre - i0 * qim, o1 = r1 * qre - i1 * qim, m0 = i0 * qre + r0 * qim, m1 = i1 * qre + r1 * qim;
                const int ln = (p & 31) + 32 * ch, blk = p >> 5;
                *(u32x4*)(BF + ((size_t)(g * 4 + blk) * 64 + ln) * 8) = pack8(o0, o1);
                *(u32x4*)(BF + ((size_t)(g * 4 + 2 + blk) * 64 + ln) * 8) = pack8(m0, m1); }
        }
        for (int i = gt; i < NG * 4 * 64; i += NT) { const int g = i >> 8, kk = (i >> 6) & 3, l = i & 63, c = l & 15, p0 = 16 * kk + 4 * (l >> 4);
            const f32x4 cr = *(const f32x4*)(P.in[17] + ((size_t)g * 16 + c) * 64 + p0), ci = *(const f32x4*)(P.in[18] + ((size_t)g * 16 + c) * 64 + p0);
            u32x4 w; w.x = pk2(cr[0], -ci[0]); w.y = pk2(cr[1], -ci[1]); w.z = pk2(cr[2], -ci[2]); w.w = pk2(cr[3], -ci[3]);
            *(u32x4*)((bf16_t*)(P.ws + O_CFR) + (size_t)i * 8) = w; }
    }
}

__device__ __forceinline__ void unpack8(const u32x4 w, float (&f)[8]) { f[0] = bf_lo(w.x); f[1] = bf_hi(w.x); f[2] = bf_lo(w.y); f[3] = bf_hi(w.y); f[4] = bf_lo(w.z); f[5] = bf_hi(w.z); f[6] = bf_lo(w.w); f[7] = bf_hi(w.w); }
__device__ __forceinline__ void conv_phase(KP kp, int bid, int G) {
    const Params P = *launder(kp); bid = opaque_s(bid); G = opaque_s(G);
    const int tid = opaque_v(threadIdx.x), half = tid >> 8, ch = (tid & 255) * 8;
    bf16_t* BG = (bf16_t*)(P.ws + O_BG); const bf16_t* V = (const bf16_t*)(P.ws + O_V);
    float w0[8], w1[8], w2[8];
#pragma unroll
    for (int e = 0; e < 8; ++e) { w0[e] = P.in[10][ch + e]; w1[e] = P.in[10][D + ch + e]; w2[e] = P.in[10][2 * D + ch + e]; }
    for (int item = half * G + bid; item < MV / 8; item += 2 * G) {
        const int row0 = item * 8; const bool smp = row0 >= MPROMPT;
        const int b = smp ? 0 : row0 / LP, pos0 = smp ? 0 : row0 - b * LP, seq0 = smp ? (row0 - MPROMPT) / 4 : 0;
        u32x4 vq[8], bq[8];
#pragma unroll
        for (int r = 0; r < 8; ++r) { vq[r] = *(const u32x4*)(V + (size_t)(row0 + r) * D + ch); bq[r] = *(const u32x4*)(BG + (size_t)(row0 + r) * D + ch); }
        float vm2[8], vm1[8], sm2[8], sm1[8];
        if (smp) { const float* st = P.in[2] + (size_t)seq0 * 2 * D + ch;
#pragma unroll
            for (int e = 0; e < 8; ++e) { vm2[e] = st[e]; vm1[e] = st[D + e]; sm2[e] = st[2 * D + e]; sm1[e] = st[3 * D + e]; } }
        else if (pos0 == 0) {
#pragma unroll
            for (int e = 0; e < 8; ++e) { vm2[e] = 0.f; vm1[e] = 0.f; sm2[e] = 0.f; sm1[e] = 0.f; } }
        else { unpack8(*(const u32x4*)(V + (size_t)(row0 - 2) * D + ch), vm2); unpack8(*(const u32x4*)(V + (size_t)(row0 - 1) * D + ch), vm1);
#pragma unroll
            for (int e = 0; e < 8; ++e) { sm2[e] = 0.f; sm1[e] = 0.f; } }
#pragma unroll
        for (int r = 0; r < 8; ++r) {
            if (r == 4 && smp) {
                float* o = P.out + OUT_CONVS + (size_t)seq0 * 2 * D + ch;
                *(f32x4*)o = (f32x4){vm2[0], vm2[1], vm2[2], vm2[3]}; *(f32x4*)(o + 4) = (f32x4){vm2[4], vm2[5], vm2[6], vm2[7]};
                *(f32x4*)(o + D) = (f32x4){vm1[0], vm1[1], vm1[2], vm1[3]}; *(f32x4*)(o + D + 4) = (f32x4){vm1[4], vm1[5], vm1[6], vm1[7]};
#pragma unroll
                for (int e = 0; e < 8; ++e) { vm2[e] = sm2[e]; vm1[e] = sm1[e]; } }
            float v[8], bg[8]; unpack8(vq[r], v); unpack8(bq[r], bg);
            f32x4 o0, o1;
#pragma unroll
            for (int e = 0; e < 4; ++e) { o0[e] = bg[e] * (w0[e] * vm2[e] + w1[e] * vm1[e] + w2[e] * v[e]); o1[e] = bg[e + 4] * (w0[e + 4] * vm2[e + 4] + w1[e + 4] * vm1[e + 4] + w2[e + 4] * v[e + 4]); }
            *(u32x4*)(BG + (size_t)(row0 + r) * D + ch) = pack8(o0, o1);
#pragma unroll
            for (int e = 0; e < 8; ++e) { vm2[e] = vm1[e]; vm1[e] = v[e]; } }
        if (smp || pos0 + 8 == LP) { float* o = smp ? P.out + OUT_CONVS + (size_t)(seq0 + 1) * 2 * D + ch : P.out + OUT_CONVP + (size_t)b * 2 * D + ch;
            *(f32x4*)o = (f32x4){vm2[0], vm2[1], vm2[2], vm2[3]}; *(f32x4*)(o + 4) = (f32x4){vm2[4], vm2[5], vm2[6], vm2[7]};
            *(f32x4*)(o + D) = (f32x4){vm1[0], vm1[1], vm1[2], vm1[3]}; *(f32x4*)(o + D + 4) = (f32x4){vm1[4], vm1[5], vm1[6], vm1[7]}; }
    }
}

constexpr int S5_CUT = 44;
constexpr int S5_PITCH = 68, S5_UP = 20, S5_RSQ_BYTES = 2112 * 4, S5_WLDS = 32 * S5_PITCH * 4 + 32 * S5_UP * 4 + 128;
template <int MODE>
__device__ __forceinline__ void s5_job(const Params& P, LAS unsigned char* lds, LAS unsigned char* wl, int lane, int g, int idx, int ck0, int ck1, float& hr, float& hi) {
    constexpr bool SAMPLE = (MODE == 1), LIGHT = (MODE == 2);
    const bf16_t* Hb = (const bf16_t*)(P.ws + O_H); const float* part = (const float*)(P.ws + O_PART); bf16_t* GA = (bf16_t*)(P.ws + O_ABF);
    const int t32 = lane & 31, hlf = lane >> 5, t16 = lane & 15, q = lane >> 4;
    const f32x2 ab = ((const f32x2*)(P.ws + O_ABAR))[g * 64 + lane]; const float ar = ab[0], ai = ab[1];
    bf16x8 Bf[4], Cf[4];
#pragma unroll
    for (int i = 0; i < 4; ++i) { Bf[i] = ((const bf16x8*)(P.ws + O_BFR))[(g * 4 + i) * 64 + lane]; if (!LIGHT) Cf[i] = ((const bf16x8*)(P.ws + O_CFR))[(g * 4 + i) * 64 + lane]; }
    const float* gn = P.in[6] + D;
    const f32x4 gnA0 = *(const f32x4*)(gn + 16 * g + 8 * hlf), gnA1 = *(const f32x4*)(gn + 16 * g + 8 * hlf + 4);
    const f32x4 z4 = (f32x4){0.f, 0.f, 0.f, 0.f};
    const f32x4 dE = LIGHT ? z4 : *(const f32x4*)(P.in[19] + 16 * g + 4 * q);
    const LAS float* rsq = (const LAS float*)lds;
    LAS unsigned* Hp = (LAS unsigned*)wl; LAS float* U = (LAS float*)(wl + 32 * S5_PITCH * 4);
    float c15r = 0.f, c15i = 0.f;
    const int rowbase = SAMPLE ? MPROMPT + 32 * idx : idx * LP;
    f32x4 x0 = z4, x1 = z4;
    { const size_t row = rowbase + 32 * ck0 + t32; const u32x4 w = *(const u32x4*)(Hb + row * D + 16 * g + 8 * hlf); x0 = up4lo(w); x1 = up4hi(w); }
    for (int ck = ck0; ck < ck1; ++ck) {
        const int row0 = rowbase + 32 * ck, nvalid = SAMPLE ? 32 : (LP - 32 * ck < 32 ? LP - 32 * ck : 32);
        float rs;
        if (SAMPLE) { const size_t row = row0 + t32; float ss = 0.f; const f32x4* pp = (const f32x4*)(part + row * 64 + 32 * hlf);
#pragma unroll
            for (int i = 0; i < 8; ++i) { const f32x4 v = pp[i]; ss += (v[0] + v[1]) + (v[2] + v[3]); }
            ss += __shfl_xor(ss, 32); rs = rsqrtf(ss * (1.0f / D) + EPS); }
        else rs = rsq[32 * ck + t32];
        f32x4 u0 = x0 * rs * gnA0, u1 = x1 * rs * gnA1;
        if (!SAMPLE && t32 >= nvalid) { u0 = z4; u1 = z4; }
        if (SAMPLE && hlf == 0) U[t32 * S5_UP + 16] = rs;
        union { u32x4 u; bf16x8 b; } af; af.u = pack8(u0, u1);
        if (!SAMPLE && ck + 1 < ck1) {
            const size_t row = row0 + 32 + t32; const u32x4 w = *(const u32x4*)(Hb + row * D + 16 * g + 8 * hlf); x0 = up4lo(w); x1 = up4hi(w); }
        const f32x16 z16 = {0.f, 0.f, 0.f, 0.f, 0.f, 0.f, 0.f, 0.f, 0.f, 0.f, 0.f, 0.f, 0.f, 0.f, 0.f, 0.f};
        f32x16 R0 = __builtin_amdgcn_mfma_f32_32x32x16_bf16(af.b, Bf[0], z16, 0, 0, 0);
        f32x16 R1 = __builtin_amdgcn_mfma_f32_32x32x16_bf16(af.b, Bf[1], z16, 0, 0, 0);
        f32x16 I0 = __builtin_amdgcn_mfma_f32_32x32x16_bf16(af.b, Bf[2], z16, 0, 0, 0);
        f32x16 I1 = __builtin_amdgcn_mfma_f32_32x32x16_bf16(af.b, Bf[3], z16, 0, 0, 0);
#pragma unroll
        for (int i = 0; i < 16; ++i) {
            auto sr = __builtin_amdgcn_permlane32_swap(__float_as_uint(R0[i]), __float_as_uint(R1[i]), false, false); R0[i] = __uint_as_float(sr[0]); R1[i] = __uint_as_float(sr[1]);
            auto si = __builtin_amdgcn_permlane32_swap(__float_as_uint(I0[i]), __float_as_uint(I1[i]), false, false); I0[i] = __uint_as_float(si[0]); I1[i] = __uint_as_float(si[1]); }
        float h0r[8], h0i[8];
        if (SAMPLE) {
#pragma unroll
            for (int s = 0; s < 8; ++s) { const size_t o = ((size_t)(8 * idx + s) * NG + g) * NST + lane; h0r[s] = P.in[3][o]; h0i[s] = P.in[4][o]; } }
#pragma unroll
        for (int t = 0; t < 32; ++t) {
            const int i = 4 * (t >> 3) + (t & 3); const bool up = (t >> 2) & 1;
            const float bre = up ? R1[i] : R0[i], bim = up ? I1[i] : I0[i];
            if (SAMPLE && (t & 3) == 0) { hr = h0r[t >> 2]; hi = h0i[t >> 2]; }
            const float nr = fmaf(ar, hr, fmaf(-ai, hi, bre)), ni = fmaf(ar, hi, fmaf(ai, hr, bim));
            hr = nr; hi = ni;
            if (!LIGHT) Hp[t * S5_PITCH + lane] = pk2(nr, ni);
            if (MODE == 0 && t == 15) { c15r = nr; c15i = ni; }
            if (SAMPLE && (t & 3) == 3) { const size_t o = ((size_t)(8 * idx + (t >> 2)) * NG + g) * NST + lane; P.out[OUT_RES + o] = nr; P.out[OUT_IMS + o] = ni; }
        }
        if (!LIGHT) {
        asm volatile("s_waitcnt lgkmcnt(0)" ::: "memory");
#pragma unroll
        for (int tb = 0; tb < 2; ++tb) {
            f32x4 y = z4;
#pragma unroll
            for (int kk = 0; kk < 4; ++kk) { const bf16x8 hf = *(const LAS bf16x8*)(Hp + (16 * tb + t16) * S5_PITCH + 16 * kk + 4 * q);
                y = __builtin_amdgcn_mfma_f32_16x16x32_bf16(Cf[kk], hf, y, 0, 0, 0); }
            const int t = 16 * tb + t16;
            if (t < nvalid) { const size_t r2 = row0 + t; const float rs2 = SAMPLE ? U[t * S5_UP + 16] : rsq[32 * ck + t];
                const f32x4 uu = up4(*(const u32x2*)(Hb + r2 * D + 16 * g + 4 * q)) * rs2 * *(const f32x4*)(gn + 16 * g + 4 * q);
                f32x4 o;
#pragma unroll
                for (int e = 0; e < 4; ++e) { const float yy = y[e] + dE[e] * uu[e];
                    const float z = 1.5957691216057308f * (yy + 0.044715f * yy * yy * yy); o[e] = yy * __builtin_amdgcn_rcpf(1.0f + __expf(-z)); }
                u32x2 w; w.x = pk2(o[0], o[1]); w.y = pk2(o[2], o[3]);
                *(u32x2*)(GA + r2 * D + 16 * g + 4 * q) = w; }
        }
        asm volatile("s_waitcnt lgkmcnt(0)" ::: "memory");
        }
    }
    if (MODE == 0 && ck1 == 65) { const size_t o = ((size_t)idx * NG + g) * NST + lane; P.out[OUT_REP + o] = c15r; P.out[OUT_IMP + o] = c15i; }
}
__device__ __forceinline__ void s5_phase(KP kp, LAS unsigned char* lds, int bid, int G) {
    const Params P = *launder(kp); bid = opaque_s(bid); G = opaque_s(G);
    const int tid = opaque_v(threadIdx.x), lane = tid & 63, wave = __builtin_amdgcn_readfirstlane(tid >> 6);
    LAS unsigned char* wl = lds + S5_RSQ_BYTES + wave * S5_WLDS;
    const float* part = (const float*)(P.ws + O_PART);
    bool first = true;
    for (int pb = bid; pb < 256 || first; pb += G) {
        const int b = pb >> 6, sg = (pb >> 5) & 1, ck0 = sg ? S5_CUT : 0, ck1 = sg ? 65 : S5_CUT;
        if (pb < 256) {
            LAS float* rsq = (LAS float*)lds; const int rend = 32 * ck1 < LP ? 32 * ck1 : LP;
            for (int r = tid; r < rend; r += NTHREADS) { const f32x4* pp = (const f32x4*)(part + (size_t)(b * LP + r) * 64); float ss = 0.f;
#pragma unroll
                for (int i = 0; i < 16; ++i) { const f32x4 v = pp[i]; ss += (v[0] + v[1]) + (v[2] + v[3]); }
                rsq[r] = rsqrtf(ss * (1.0f / D) + EPS); }
        }
        __syncthreads();
        if (wave < 4) { if (pb < 256) { const int g = 4 * (pb & 31) + wave; float hr = 0.f, hi = 0.f;
            if (ck0 > 0) s5_job<2>(P, lds, wl, lane, g, b, 0, ck0, hr, hi);
            s5_job<0>(P, lds, wl, lane, g, b, ck0, ck1, hr, hi); } }
        if (wave < 4 && first) { for (int sj = bid * 4 + wave; sj < 16 * NG; sj += 4 * G) { float hr = 0.f, hi = 0.f; s5_job<1>(P, lds, wl, lane, sj % NG, sj / NG, 0, 1, hr, hi); } }
        first = false;
        __syncthreads();
    }
}


__device__ __forceinline__ float* slot_ptr(unsigned char* ws, int slot) { return (float*)(ws + (slot < 128 ? O_WIN + (size_t)slot * 262144 : O_ABF + (size_t)(slot - 128) * 262144)); }
__device__ __forceinline__ void final_phase(KP kp, int bid, int G) {
    const Params P = *launder(kp); bid = opaque_s(bid); G = opaque_s(G);
    const int tid = opaque_v(threadIdx.x), lane = tid & 63, wave = __builtin_amdgcn_readfirstlane(tid >> 6);
    const bf16_t* H = (const bf16_t*)(P.ws + O_H); const float* gf = P.in[8];
    pg8::StaticOrder SO; SO.init(MP, 2048, G, 0, SPLIT_DN);
    const bool split = !(SO.nwg % G == 0 || (long)(SO.nwg % G) * SPLIT_DN > G);
    const int ntail = split ? SO.nwg - SO.nfull : 0;
    for (int row = wave * G + bid; row < MV; row += 8 * G) {
        float* o;
        if (row < MPROMPT) { const int b = row / LP, pos = row % LP; if (pos < 16) continue; o = P.out + OUT_YP + ((size_t)b * 2048 + (pos - 16)) * D; }
        else o = P.out + OUT_YS + (size_t)(row - MPROMPT) * D;
        f32x4 v[8];
#pragma unroll
        for (int j = 0; j < 8; ++j) v[j] = up4(*(const u32x2*)(H + (size_t)row * D + 4 * lane + 256 * j));
        const int pm = row >> 8, rl = row & 255;
        for (int tu = 0; tu < ntail; ++tu) { pg8::Unit u; SO.map(SO.nfull + tu, u);
            if (u.pm == pm) { f32x4 a = (f32x4){0.f, 0.f, 0.f, 0.f};
                for (int s2 = 0; s2 < SPLIT_DN; ++s2) a += *(const f32x4*)(slot_ptr(P.ws, tu * SPLIT_DN + s2) + (size_t)rl * 256 + 4 * lane);
#pragma unroll
                for (int j = 0; j < 8; ++j) if (j == u.pn) v[j] += a; } }
        float ss = 0.f;
#pragma unroll
        for (int j = 0; j < 8; ++j) ss += (v[j][0] * v[j][0] + v[j][1] * v[j][1]) + (v[j][2] * v[j][2] + v[j][3] * v[j][3]);
#pragma unroll
        for (int of = 1; of < 64; of <<= 1) ss += __shfl_xor(ss, of);
        const float rs = rsqrtf(ss * (1.0f / D) + EPS);
#pragma unroll
        for (int j = 0; j < 8; ++j) { const f32x4 gg = *(const f32x4*)(gf + 4 * lane + 256 * j); *(f32x4*)(o + 4 * lane + 256 * j) = v[j] * rs * gg; }
    }
}
struct EpiAll {
    int mode; bf16_t* H; float* part; bf16_t* O; bf16_t* O2; unsigned char* ws; KP kp; const LAS float* rstab;
    __device__ __forceinline__ void operator()(const f32x4 (&acc)[2][2][4][2], const pg8::Unit& u, int wr, int wc, int fr, int fq) const {
        if (u.ks >= 0) {
            float* Pp = slot_ptr(ws, u.slot) + (size_t)(wr * 64 + fr) * 256 + 32 * wc + 8 * fq;
#pragma unroll
            for (int ai = 0; ai < 2; ++ai)
#pragma unroll
                for (int m = 0; m < 4; ++m)
#pragma unroll
                    for (int bj = 0; bj < 2; ++bj) { float* p = Pp + (size_t)(ai * 128 + m * 16) * 256 + 128 * bj; *(f32x4*)p = acc[ai][bj][m][0]; *(f32x4*)(p + 4) = acc[ai][bj][m][1]; }
        }
        else if (mode == 0) { EpiG1 e{O, O2}; e(acc, u, wr, wc, fr, fq); }
        else if (mode == 1) { EpiRes<true> e{H, part, O, kp}; e(acc, u, wr, wc, fr, fq); }
        else if (mode == 2) { EpiUp e{rstab, O}; e(acc, u, wr, wc, fr, fq); }
        else if (mode == 3) { EpiRes<false> e{H, part, nullptr, kp}; e(acc, u, wr, wc, fr, fq); }
        else { EpiGlu e{H, part, O}; e(acc, u, wr, wc, fr, fq); }
    }
};
__device__ __forceinline__ void reduce_phase(KP kp, int bid, int G, int S, bool wbf) {
    const Params P = *launder(kp); bid = opaque_s(bid); G = opaque_s(G);
    const int tid = opaque_v(threadIdx.x), lane = tid & 63, wave = tid >> 6;
    bf16_t* H = (bf16_t*)(P.ws + O_H); float* part = (float*)(P.ws + O_PART);
    pg8::StaticOrder SO; SO.init(MP, 2048, G, 0, S);
    if (SO.nwg % G == 0 || (long)(SO.nwg % G) * S > G) return;
    const int ntail = SO.nwg - SO.nfull;
    constexpr int RB = 3;
    for (int w0 = wave * G + bid; w0 < ntail * 256; w0 += RB * 8 * G) {
        f32x4 a[RB], res[RB]; int tuv[RB], rv[RB], pmv[RB], pnv[RB];
#pragma unroll
        for (int k = 0; k < RB; ++k) { const int w = w0 + k * 8 * G; const bool ok = w < ntail * 256; const int ww = ok ? w : w0;
            tuv[k] = ww >> 8; rv[k] = ww & 255; pg8::Unit u; SO.map(SO.nfull + tuv[k], u); pmv[k] = u.pm; pnv[k] = ok ? u.pn : -1;
            a[k] = (f32x4){0.f, 0.f, 0.f, 0.f};
            for (int s2 = 0; s2 < S; ++s2) a[k] += *(const f32x4*)(slot_ptr(P.ws, tuv[k] * S + s2) + (size_t)rv[k] * 256 + 4 * lane);
            const size_t off = (size_t)(pmv[k] * 256 + rv[k]) * D + u.pn * 256 + 4 * lane;
            res[k] = wbf ? *(const f32x4*)(xsrc(kp, pmv[k] * 256 + rv[k]) + u.pn * 256 + 4 * lane) : up4(*(const u32x2*)(H + off)); }
#pragma unroll
        for (int k = 0; k < RB; ++k) { if (pnv[k] < 0) continue;
            const size_t row = (size_t)(pmv[k] * 256 + rv[k]);
            const f32x4 h = res[k] + a[k]; { u32x2 o; o.x = pk2(h[0], h[1]); o.y = pk2(h[2], h[3]); *(u32x2*)(H + row * D + pnv[k] * 256 + 4 * lane) = o; }
            float ss = (h[0] * h[0] + h[1] * h[1]) + (h[2] * h[2] + h[3] * h[3]);
            ss += __shfl_xor(ss, 1); ss += __shfl_xor(ss, 2); ss += __shfl_xor(ss, 4);
            if ((lane & 7) == 0) part[row * 64 + 8 * pnv[k] + (lane >> 3)] = ss;
            }
    }
}

#define XB_TMO      128
#define XB_XCNT(j)  (256  + 64 * (j))
#define XB_XSUB(j)  (1280 + 64 * (j))
#define XB_XGEN(j)  (2304 + 64 * (j))
#define XB_TOP      3328
#define XB_TOPGEN   3392
#define XCD_BAR_WORDS 3456
#define XB_SPIN_CAP (1u << 18)
__device__ __forceinline__ unsigned xb_ld(unsigned* p)              { return __hip_atomic_load(p, __ATOMIC_RELAXED, __HIP_MEMORY_SCOPE_AGENT); }
__device__ __forceinline__ unsigned xb_add(unsigned* p, unsigned v) { return __hip_atomic_fetch_add(p, v, __ATOMIC_RELAXED, __HIP_MEMORY_SCOPE_AGENT); }
__device__ __forceinline__ unsigned xb_xcc_id() { return (unsigned)__builtin_amdgcn_s_getreg((3 << 11) | 20) & 0xFu; }
#define XB_SPIN(cond, bar) do { unsigned _sp = 0; while (cond) { __builtin_amdgcn_s_sleep(1); \
    if ((++_sp & 255u) == 0u) { if (xb_ld(&(bar)[XB_TMO])) break; if (_sp > XB_SPIN_CAP) { atomicAdd(&(bar)[XB_TMO], 1u); break; } } } } while (0)
__device__ __forceinline__ void xcd_barrier_complete(unsigned* bar, unsigned x, unsigned G, unsigned& nloc, unsigned& nx) {
    unsigned sum, cnt, mine, sp = 0u;
    for (;;) {
        sum = 0u; cnt = 0u; mine = 0u;
#pragma unroll
        for (unsigned j = 0; j < 16; ++j) { const unsigned c = xb_ld(&bar[XB_XCNT(j)]); sum += c; cnt += (c > 0u) ? 1u : 0u; mine = (j == x) ? c : mine; }
        if (sum == G) break;
        __builtin_amdgcn_s_sleep(1);
        if ((++sp & 255u) == 0u) { if (xb_ld(&bar[XB_TMO])) break; if (sp > XB_SPIN_CAP) { atomicAdd(&bar[XB_TMO], 1u); break; } }
    }
    nloc = mine > 0u ? mine : 1u; nx = cnt > 0u ? cnt : 1u;
}
__device__ __forceinline__ void xcd_barrier(unsigned* bar, volatile LAS unsigned* st) {
    asm volatile("s_waitcnt vmcnt(0)" ::: "memory");
    __syncthreads();
    if (threadIdx.x == 0) {
        __builtin_amdgcn_s_waitcnt(0);
        const unsigned x = xb_xcc_id();
        unsigned nloc = st[0], nx = st[1];
        if (nloc == 0u) { xcd_barrier_complete(bar, x, gridDim.x, nloc, nx); st[0] = nloc; st[1] = nx; }
        const unsigned old = xb_add(&bar[XB_XSUB(x)], 1u);
        const unsigned gen = old / nloc;
        if (old + 1u == (gen + 1u) * nloc) {
            __builtin_amdgcn_fence(__ATOMIC_RELEASE, "agent");
            asm volatile("s_waitcnt vmcnt(0)" ::: "memory");
            const unsigned og = xb_add(&bar[XB_TOP], 1u);
            const unsigned tg = og / nx;
            if (og + 1u == (tg + 1u) * nx) xb_add(&bar[XB_TOPGEN], 1u);
            else XB_SPIN(xb_ld(&bar[XB_TOPGEN]) == tg, bar);
            __builtin_amdgcn_fence(__ATOMIC_ACQUIRE, "agent");
            xb_add(&bar[XB_XGEN(x)], 1u);
            asm volatile("s_waitcnt vmcnt(0)" ::: "memory");
        } else {
            XB_SPIN(xb_ld(&bar[XB_XGEN(x)]) == gen, bar);
            __builtin_amdgcn_fence(__ATOMIC_ACQUIRE, "agent");
            asm volatile("s_waitcnt vmcnt(0)" ::: "memory");
        }
    }
    __syncthreads();
}

__global__ void __launch_bounds__(NTHREADS, 2) fwd_kernel(Params Parg) {
    extern __shared__ __attribute__((aligned(16))) unsigned char shm[];
    LAS unsigned char* lds = (LAS unsigned char*)shm;
    const int bid = blockIdx.x, G = gridDim.x;
    KP kp = (KP)__builtin_amdgcn_kernarg_segment_ptr();
    const int ph_lo = kp->ph_lo, ph_hi = kp->ph_hi;
    volatile LAS unsigned* xst = (volatile LAS unsigned*)(lds + pg8::STAGE_BYTES);
    if (threadIdx.x == 0) { xst[0] = 0u; xst[1] = 0u; (void)xb_add((unsigned*)(kp->ws + O_BAR) + XB_XCNT(xb_xcc_id()), 1u); }
    __syncthreads();
    for (int ph = ph_lo; ph < ph_hi; ++ph) {
        if (ph == 0) prep_phase(kp, lds, bid, G);
        else if (ph == 2) conv_phase(kp, bid, G);
        else if (ph == 8) s5_phase(kp, lds, bid, G);
        else if (ph == 12) final_phase(kp, bid, G);
        else if (ph == 4) reduce_phase(kp, bid, G, SPLIT_G2, true);
        else if (ph == 7) reduce_phase(kp, bid, G, SPLIT_DN, false);
        else {
            size_t oa, ob, oo, oo2 = 0; int N, K, mode, S = 1;
            if (ph == 1) { oa = O_ABF; ob = O_WIN; N = 6144; K = 2048; mode = 0; oo = O_V; oo2 = O_BG; }
            else if (ph == 3) { oa = O_BG; ob = O_WOUT; N = 2048; K = 2048; mode = 1; oo = O_ABF; S = SPLIT_G2; }
            else if (ph == 5) { oa = O_H; ob = O_WUP0; N = 8192; K = 2048; mode = 2; oo = O_ACT; }
            else if (ph == 6) { oa = O_ACT; ob = O_WDN0; N = 2048; K = 8192; mode = 3; oo = 0; S = SPLIT_DN; }
            else if (ph == 9) { oa = O_ABF; ob = O_WGLU; N = 4096; K = 2048; mode = 4; oo = O_ABF2; }
            else if (ph == 10) { oa = O_H; ob = O_WUP1; N = 8192; K = 2048; mode = 2; oo = O_ACT; }
            else { oa = O_ACT; ob = O_WDN1; N = 2048; K = 8192; mode = 3; oo = 0; S = SPLIT_DN; }
            unsigned char* ws = launder(kp)->ws;
            if ((N / 256) * (MP / 256) % G == 0 || (long)((N / 256) * (MP / 256) % G) * S > G) S = 1;
            pg8::Gemm g{(const bf16_t*)(ws + oa), (const bf16_t*)(ws + ob), MP, N, K}; pg8::StaticOrder S_; S_.init(MP, N, G, bid, S);
            LAS float* rstab = (LAS float*)(lds + pg8::STAGE_BYTES + 16);
            if (mode == 2) {
                const int t = opaque_v(threadIdx.x), row = t >> 1, hf = t & 1; const float* part = (const float*)(ws + O_PART);
                pg8::Unit u;
                for (int i = 0; i < RS_UNITS && S_.next(i, u); ++i) { const f32x4* pp = (const f32x4*)(part + (size_t)(u.pm * 256 + row) * 64 + 32 * hf); float ss = 0.f;
#pragma unroll
                    for (int k = 0; k < 8; ++k) { const f32x4 v = pp[k]; ss += (v[0] + v[1]) + (v[2] + v[3]); }
                    ss += __shfl_xor(ss, 1);
                    if (hf == 0) rstab[i * 256 + row] = rsqrtf(ss * (1.0f / D) + EPS); }
                __syncthreads();
            }
            EpiAll E{mode, (bf16_t*)(ws + O_H), (float*)(ws + O_PART), (bf16_t*)(ws + oo), (bf16_t*)(ws + oo2), ws, kp, rstab};
            pg8::gemm_phase(lds, g, S_, E);
            if (ph == 1 || ph == 5 || ph == 9 || ph == 10) { const int r = ((N / 256) * (MP / 256)) % G;
                const int j0 = ph == 1 ? 6144 : (ph == 5 ? 16384 : (ph == 9 ? 28672 : 36864)), j1 = ph == 1 ? 16384 : (ph == 5 ? 28672 : (ph == 9 ? 36864 : 45056));
                if (r == 0) filler_phase(kp, bid, G, 0, j0, j1); else if (bid >= r) filler_phase(kp, bid, G, r, j0, j1); }
        }
        if (ph + 1 < ph_hi) {
            if (ph_hi > 1000) { __syncthreads(); cg::this_grid().sync(); }
            else xcd_barrier((unsigned*)(launder(kp)->ws + O_BAR), xst);
        }
    }
}

constexpr int LDS_BYTES = pg8::STAGE_BYTES + 16 + RS_UNITS * 256 * 4;
extern "C" void kernel_launch(void* const* d_in, const int* in_sizes, int n_in, void* d_out, int out_size, void* d_ws, size_t ws_size, hipStream_t stream) {
    static int grid = 0;
    if (grid == 0) {
        if (n_in != 24 || ws_size < O_END) { fprintf(stderr, "kernel_launch: unexpected n_in %d or ws_size %zu (< %zu)\n", n_in, ws_size, (size_t)O_END); grid = -1; return; }
        int dev = 0, cus = 0, per_cu = 0;
        hipGetDevice(&dev); hipDeviceGetAttribute(&cus, hipDeviceAttributeMultiprocessorCount, dev);
        hipFuncSetAttribute((const void*)fwd_kernel, hipFuncAttributeMaxDynamicSharedMemorySize, LDS_BYTES);
        hipOccupancyMaxActiveBlocksPerMultiprocessor(&per_cu, (const void*)fwd_kernel, NTHREADS, LDS_BYTES);
        if (per_cu < 1) per_cu = 1;
        (void)hipGetLastError();
        grid = cus * 1;
        (void)per_cu;
    }
    if (grid < 0) return;
    if (hipMemsetAsync((char*)d_ws + O_BAR, 0, 16384, stream) != hipSuccess) return;
    Params p{};
    for (int i = 0; i < 24; ++i) p.in[i] = (const float*)d_in[i];
    p.out = (float*)d_out; p.ws = (unsigned char*)d_ws;
#if N_LAUNCH_MODE == 1
    p.ph_lo = 0; p.ph_hi = NPHASES;
    void* args[] = {&p};
    hipError_t e = hipLaunchCooperativeKernel((const void*)fwd_kernel, dim3(grid), dim3(NTHREADS), args, LDS_BYTES, stream);
    if (e != hipSuccess) fprintf(stderr, "cooperative launch failed: %s (grid %d)\n", hipGetErrorString(e), grid);
#else
    for (int ph = 0; ph < NPHASES; ++ph) { if (!((DBG_LAUNCH_MASK >> ph) & 1)) continue; p.ph_lo = ph; p.ph_hi = ph + 1; hipLaunchKernelGGL(fwd_kernel, dim3(grid), dim3(NTHREADS), LDS_BYTES, stream, p); }
#endif
}
```

```cpp
#include <hip/hip_runtime.h>
#include <hip/hip_cooperative_groups.h>
#include <cstdio>
namespace cg = cooperative_groups;

#ifndef PHMASK
#define PHMASK 2047
#endif
#ifndef DBG_LAUNCH_MASK
#define DBG_LAUNCH_MASK 0x1FFF
#endif
#ifndef DBL_PHASE
#define DBL_PHASE -1
#define DBL_REPS 0
#endif
#ifndef N_LAUNCH_MODE
#define N_LAUNCH_MODE 1
#endif

#define LAS __attribute__((address_space(3)))
typedef unsigned short bf16_t;
typedef short bf16x8 __attribute__((ext_vector_type(8)));
typedef float f32x4 __attribute__((ext_vector_type(4)));
typedef float f32x2 __attribute__((ext_vector_type(2)));
typedef float f32x16 __attribute__((ext_vector_type(16)));
typedef unsigned u32x4 __attribute__((ext_vector_type(4)));
typedef unsigned u32x2 __attribute__((ext_vector_type(2)));

constexpr int D = 2048, FF = 8192, LP = 2064, NB = 4, MPROMPT = NB * LP  , NSEQ = 128, MV = MPROMPT + NSEQ * 4  , MP = 8960;
constexpr int NG = 128, NST = 64;
constexpr float EPS = 1e-6f;
constexpr int NTHREADS = 512, NPHASES = 13;
constexpr int RS_UNITS = 8;
constexpr int SPLIT_G2 = 4, SPLIT_DN = 8;

constexpr size_t O_WIN = 0;
constexpr size_t O_WOUT = O_WIN + (size_t)6144 * 2048 * 2;
constexpr size_t O_WUP0 = O_WOUT + (size_t)2048 * 2048 * 2;
constexpr size_t O_WDN0 = O_WUP0 + (size_t)8192 * 2048 * 2;
constexpr size_t O_WGLU = O_WDN0 + (size_t)8192 * 2048 * 2;
constexpr size_t O_WUP1 = O_WGLU + (size_t)4096 * 2048 * 2;
constexpr size_t O_WDN1 = O_WUP1 + (size_t)8192 * 2048 * 2;
constexpr size_t O_H = O_WDN1 + (size_t)8192 * 2048 * 2;
constexpr size_t O_ABF = O_H + (size_t)MP * D * 4;
constexpr size_t O_ACT = O_ABF + (size_t)MP * D * 2;
constexpr size_t O_PART = O_ACT + (size_t)MP * FF * 2;
constexpr size_t O_ABAR = O_PART + (size_t)MP * 64 * 4;
constexpr size_t O_BFR = O_ABAR + (size_t)NG * NST * 8;
constexpr size_t O_CFR = O_BFR + (size_t)NG * 4 * 64 * 16;
constexpr size_t O_BAR = O_CFR + (size_t)NG * 4 * 64 * 16;
constexpr size_t O_END = O_BAR + 16384;
constexpr size_t O_BG = O_ACT;
constexpr size_t O_V = O_ACT + (size_t)MP * D * 2;
constexpr size_t O_ABF2 = O_WUP0;

constexpr size_t OUT_YP = 0, OUT_YS = 16777216, OUT_CONVP = 17825792, OUT_REP = 17842176, OUT_IMP = 17874944, OUT_CONVS = 17907712, OUT_RES = 18432000, OUT_IMS = 19480576;

struct Params { const float* in[24]; float* out; unsigned char* ws; int ph_lo, ph_hi; };
#if defined(__HIP_DEVICE_COMPILE__)
typedef const __attribute__((address_space(4))) Params* KP;
#else
typedef const Params* KP;
#endif
__device__ __forceinline__ KP launder(KP p) { asm volatile("" : "+s"(p)); return p; }
__device__ __forceinline__ int opaque_v(int v) { asm volatile("" : "+v"(v)); return v; }
__device__ __forceinline__ int opaque_s(int v) { asm volatile("" : "+s"(v)); return v; }

typedef __bf16 bf16x2_t __attribute__((ext_vector_type(2)));
__device__ __forceinline__ unsigned pk2(float lo, float hi) { f32x2 v = {lo, hi}; bf16x2_t b = __builtin_convertvector(v, bf16x2_t); return __builtin_bit_cast(unsigned, b); }
__device__ __forceinline__ float bf_lo(unsigned w) { return __uint_as_float(w << 16); }
__device__ __forceinline__ float bf_hi(unsigned w) { return __uint_as_float(w & 0xffff0000u); }

namespace pg8 {
constexpr int BM = 256, BK = 64, HALF = 128, HTB = HALF * BK * 2, STAGE_BYTES = 8 * HTB, NXCD = 8, WGM = 8;
__device__ __forceinline__ int lds_byte(int r, int c) { const int st = (r >> 4) * 2 + (c >> 5), rr = r & 15, cc = c & 31, ob = rr * 64 + cc * 2; return st * 1024 + (ob ^ (((ob >> 9) & 1) << 5)); }
__device__ __forceinline__ void stage_rc(int b, int& R, int& C) { const int st = b / 1024, sb = b % 1024, swz = sb ^ (((sb >> 9) & 1) << 5); R = (st >> 1) * 16 + swz / 64; C = (st & 1) * 32 + (swz % 64) / 2; }
__device__ __forceinline__ int perm32(int rho) { const int n = rho >> 4, i = rho & 15; return 8 * (i >> 2) + 4 * n + (i & 3); }
struct Unit { int pm, pn, ks, slot; };
struct Gemm { const bf16_t* A; const bf16_t* Bt; int M, N, K; };
struct StaticOrder {
    int nM, nN, nwg, G, c, S, nfull;
    __device__ void init(int M, int N, int G_, int c_, int S_) { nM = M / BM; nN = N / BM; nwg = nM * nN; G = G_; c = c_; S = S_; nfull = (S_ > 1) ? (nwg / G_) * G_ : nwg; }
    __device__ void map(int wgid, Unit& u) const {
        { const int q = nwg / NXCD, r = nwg % NXCD, xcd = wgid % NXCD, off = wgid / NXCD; wgid = (xcd < r ? xcd * (q + 1) : r * (q + 1) + (xcd - r) * q) + off; }
        const int nig = WGM * nN, gid = wgid / nig, fm = gid * WGM, gsz = (nM - fm) < WGM ? (nM - fm) : WGM;
        u.pm = fm + ((wgid % nig) % gsz); u.pn = (wgid % nig) / gsz;
    }
    __device__ bool next(int i, Unit& u) const {
        const long L = (long)i * G + c;
        if (L < nfull) { map((int)L, u); u.ks = -1; u.slot = i; return true; }
        const long j = L - nfull; if (j >= (long)(nwg - nfull) * S) return false;
        map(nfull + (int)j / S, u); u.ks = (int)j % S; u.slot = (int)j; return true;
    }
};

template <class Epi>
__device__ __forceinline__ void gemm_phase(LAS unsigned char* lds, const Gemm g, const StaticOrder& S, const Epi& E) {
    const int tid = opaque_v(threadIdx.x), wid = __builtin_amdgcn_readfirstlane(tid >> 6), lane = tid & 63, wr = wid >> 2, wc = wid & 3, fr = lane & 15, fq = lane >> 4;
    const int K = g.K, KS = K / S.S;
    unsigned voffA[2], voffB[2];
#pragma unroll
    for (int i = 0; i < 2; ++i) { int R, C; stage_rc(tid * 16 + i * 8192, R, C); const int Rb = (R & ~31) + perm32(R & 31);
        voffA[i] = (unsigned)(R * K + C) * 2u; voffB[i] = (unsigned)(Rb * K + C) * 2u; }
    const size_t kstep = (size_t)(BK * 2);
    const size_t hstep = (size_t)HALF * K * 2;
    const size_t tstep = 2 * hstep;
    const unsigned ldsw = (unsigned)wid * 1024u;
    const int aoff = lds_byte(wr * 64 + fr, fq * 8), boff = lds_byte(wc * 32 + fr, fq * 8);
#define PG8_SA(b, h) (((b) * 2 + (h)) * HTB)
#define PG8_SB(b, h) ((4 + (b) * 2 + (h)) * HTB)
#define PG8_STAGE(bufoff, gbase, voff) do { _Pragma("unroll") for (int _i = 0; _i < 2; ++_i) \
        __builtin_amdgcn_global_load_lds((const unsigned*)((const char*)(gbase) + (voff)[_i]), (LAS unsigned*)(lds + (bufoff) + ldsw + _i * 8192), 16, 0, 0); } while (0)
#define PG8_LDA(dst, b, h) do { _Pragma("unroll") for (int m = 0; m < 4; ++m) _Pragma("unroll") for (int k = 0; k < 2; ++k) dst[m][k] = *(const LAS bf16x8*)(lds + PG8_SA(b, h) + aoff + m * 2048 + k * 1024); } while (0)
#define PG8_LDB(dst, b, h) do { _Pragma("unroll") for (int n = 0; n < 2; ++n) _Pragma("unroll") for (int k = 0; k < 2; ++k) dst[n][k] = *(const LAS bf16x8*)(lds + PG8_SB(b, h) + boff + n * 2048 + k * 1024); } while (0)
#define PG8_MMA(ai, bj, At, Bt) do { __builtin_amdgcn_s_setprio(1); _Pragma("unroll") for (int m = 0; m < 4; ++m) _Pragma("unroll") for (int n = 0; n < 2; ++n) _Pragma("unroll") for (int k = 0; k < 2; ++k) \
        acc[ai][bj][m][n] = __builtin_amdgcn_mfma_f32_16x16x32_bf16(Bt[n][k], At[m][k], acc[ai][bj][m][n], 0, 0, 0); __builtin_amdgcn_s_setprio(0); } while (0)
#define PG8_WAIT_V(n) asm volatile("s_waitcnt vmcnt(" #n ")" ::: "memory")
#define PG8_WAIT_L(n) asm volatile("s_waitcnt lgkmcnt(" #n ")" ::: "memory")
#define PG8_BAR __builtin_amdgcn_s_barrier()
#define PG8_SCHED __builtin_amdgcn_sched_barrier(0)
    Unit cur, nxt; int ui = 0;
    if (!S.next(0, cur)) return;
    f32x4 acc[2][2][4][2];
#pragma unroll
    for (int a = 0; a < 2; ++a)
#pragma unroll
        for (int b = 0; b < 2; ++b)
#pragma unroll
            for (int m = 0; m < 4; ++m)
#pragma unroll
                for (int n = 0; n < 2; ++n) acc[a][b][m][n] = (f32x4){0.f, 0.f, 0.f, 0.f};
    bf16x8 At[4][2], B0[2][2], B1[2][2];
    size_t koff = cur.ks < 0 ? 0 : (size_t)cur.ks * KS * 2; int nt = (cur.ks < 0 ? K : KS) / BK;
    const char* cA = (const char*)g.A + (size_t)cur.pm * tstep + koff; const char* cB = (const char*)g.Bt + (size_t)cur.pn * tstep + koff;
    PG8_STAGE(PG8_SB(0, 0), cB, voffB); PG8_STAGE(PG8_SA(0, 0), cA, voffA); PG8_STAGE(PG8_SB(0, 1), cB + hstep, voffB); PG8_STAGE(PG8_SA(0, 1), cA + hstep, voffA);
    if (wr == 1) PG8_BAR;
    PG8_WAIT_V(4); PG8_BAR;
    PG8_STAGE(PG8_SB(1, 0), cB + kstep, voffB); PG8_STAGE(PG8_SA(1, 0), cA + kstep, voffA); PG8_STAGE(PG8_SB(1, 1), cB + hstep + kstep, voffB);
    PG8_WAIT_V(6); PG8_BAR;
    for (;;) {
        const bool has_next = S.next(ui + 1, nxt);
        const size_t nkoff = (has_next && nxt.ks >= 0) ? (size_t)nxt.ks * KS * 2 : 0;
        const char* nA = has_next ? (const char*)g.A + (size_t)nxt.pm * tstep + nkoff : cA; const char* nB = has_next ? (const char*)g.Bt + (size_t)nxt.pn * tstep + nkoff : cB;
        for (int t = 0; t < nt; t += 2) {
            const bool last = (t == nt - 2);
            const char* a1 = cA + (size_t)(t + 1) * kstep;
            const char* a2 = last ? nA : cA + (size_t)(t + 2) * kstep; const char* b2 = last ? nB : cB + (size_t)(t + 2) * kstep;
            const char* a3 = a2 + kstep; const char* b3 = b2 + kstep;
            PG8_LDB(B0, 0, 0); PG8_SCHED; PG8_LDA(At, 0, 0); PG8_STAGE(PG8_SA(1, 1), a1 + hstep, voffA);
            PG8_WAIT_L(8); PG8_BAR; PG8_WAIT_L(0); PG8_MMA(0, 0, At, B0); PG8_BAR; PG8_SCHED;
            PG8_LDB(B1, 0, 1); PG8_STAGE(PG8_SB(0, 0), b2, voffB);
            PG8_BAR; PG8_WAIT_L(0); PG8_MMA(0, 1, At, B1); PG8_BAR;
            PG8_LDA(At, 0, 1); PG8_STAGE(PG8_SA(0, 0), a2, voffA);
            PG8_BAR; PG8_WAIT_L(0); PG8_MMA(1, 0, At, B0); PG8_BAR; PG8_SCHED;
            PG8_STAGE(PG8_SB(0, 1), b2 + hstep, voffB);
            PG8_WAIT_V(6); PG8_BAR; PG8_MMA(1, 1, At, B1); PG8_BAR;
            PG8_LDB(B0, 1, 0); PG8_SCHED; PG8_LDA(At, 1, 0); PG8_STAGE(PG8_SA(0, 1), a2 + hstep, voffA);
            PG8_WAIT_L(8); PG8_BAR; PG8_WAIT_L(0); PG8_MMA(0, 0, At, B0); PG8_BAR; PG8_SCHED;
            PG8_LDB(B1, 1, 1); PG8_STAGE(PG8_SB(1, 0), b3, voffB);
            PG8_BAR; PG8_WAIT_L(0); PG8_MMA(0, 1, At, B1); PG8_BAR;
            PG8_LDA(At, 1, 1); PG8_STAGE(PG8_SA(1, 0), a3, voffA);
            PG8_BAR; PG8_WAIT_L(0); PG8_MMA(1, 0, At, B0); PG8_BAR; PG8_SCHED;
            PG8_STAGE(PG8_SB(1, 1), b3 + hstep, voffB);
            PG8_WAIT_V(6); PG8_BAR; PG8_MMA(1, 1, At, B1); PG8_BAR;
        }
        E(acc, cur, wr, wc, fr, fq);
        if (!has_next) break;
#pragma unroll
        for (int a = 0; a < 2; ++a)
#pragma unroll
            for (int b = 0; b < 2; ++b)
#pragma unroll
                for (int m = 0; m < 4; ++m)
#pragma unroll
                    for (int n = 0; n < 2; ++n) acc[a][b][m][n] = (f32x4){0.f, 0.f, 0.f, 0.f};
        cur = nxt; cA = nA; cB = nB; ++ui; nt = (cur.ks < 0 ? K : KS) / BK;
    }
    PG8_WAIT_V(0);
    if (wr == 0) PG8_BAR;
    PG8_BAR;
#undef PG8_SA
#undef PG8_SB
#undef PG8_STAGE
#undef PG8_LDA
#undef PG8_LDB
#undef PG8_MMA
#undef PG8_WAIT_V
#undef PG8_WAIT_L
#undef PG8_BAR
#undef PG8_SCHED
}
}

__device__ __forceinline__ f32x4 up4lo(const u32x4 w) { return (f32x4){bf_lo(w.x), bf_hi(w.x), bf_lo(w.y), bf_hi(w.y)}; }
__device__ __forceinline__ f32x4 up4hi(const u32x4 w) { return (f32x4){bf_lo(w.z), bf_hi(w.z), bf_lo(w.w), bf_hi(w.w)}; }
__device__ __forceinline__ f32x4 up4(const u32x2 w) { return (f32x4){bf_lo(w.x), bf_hi(w.x), bf_lo(w.y), bf_hi(w.y)}; }
__device__ __forceinline__ u32x4 pack8(const f32x4 a, const f32x4 b) { u32x4 w; w.x = pk2(a[0], a[1]); w.y = pk2(a[2], a[3]); w.z = pk2(b[0], b[1]); w.w = pk2(b[2], b[3]); return w; }

struct EpiG1 {
    bf16_t* V; bf16_t* BG;
    __device__ __forceinline__ void operator()(const f32x4 (&acc)[2][2][4][2], const pg8::Unit& u, int wr, int wc, int fr, int fq) const {
        const int row0 = u.pm * 256 + wr * 64 + fr;
        if (u.pn < 16) {
            const int ch0 = 128 * u.pn + 32 * wc + 8 * fq;
#pragma unroll
            for (int ai = 0; ai < 2; ++ai)
#pragma unroll
                for (int m = 0; m < 4; ++m) { const size_t r = row0 + ai * 128 + m * 16;
                    *(u32x4*)(V + r * D + ch0) = pack8(acc[ai][0][m][0] * acc[ai][1][m][0], acc[ai][0][m][1] * acc[ai][1][m][1]); }
        } else {
            const int c0 = 256 * (u.pn - 16) + 32 * wc + 8 * fq;
#pragma unroll
            for (int ai = 0; ai < 2; ++ai)
#pragma unroll
                for (int m = 0; m < 4; ++m) { const size_t r = row0 + ai * 128 + m * 16;
#pragma unroll
                    for (int bj = 0; bj < 2; ++bj) *(u32x4*)(BG + r * D + c0 + 128 * bj) = pack8(acc[ai][bj][m][0], acc[ai][bj][m][1]); }
        }
    }
};
__device__ __forceinline__ const float* xsrc(KP kp, int row) {
    if (row < MPROMPT) { const int b = row / LP, pos = row - b * LP; return pos < 16 ? kp->in[5] + (size_t)pos * D : kp->in[0] + ((size_t)b * 2048 + (pos - 16)) * D; }
    if (row < MV) return kp->in[1] + (size_t)(row - MPROMPT) * D;
    return kp->in[5];
}
template <bool WBF> struct EpiRes {
    bf16_t* HB; float* part; bf16_t* O; KP kp;
    __device__ __forceinline__ void operator()(const f32x4 (&acc)[2][2][4][2], const pg8::Unit& u, int wr, int wc, int fr, int fq) const {
        const int row0 = u.pm * 256 + wr * 64 + fr, c0 = 256 * u.pn + 32 * wc + 8 * fq;
#pragma unroll
        for (int ai = 0; ai < 2; ++ai) {
            f32x4 rv[4][2][2];
#pragma unroll
            for (int m = 0; m < 4; ++m) { const size_t r = row0 + ai * 128 + m * 16;
                if (WBF) { const float* rp = xsrc(kp, (int)r) + c0;
#pragma unroll
                    for (int bj = 0; bj < 2; ++bj) { rv[m][bj][0] = *(const f32x4*)(rp + 128 * bj); rv[m][bj][1] = *(const f32x4*)(rp + 128 * bj + 4); } }
                else {
#pragma unroll
                    for (int bj = 0; bj < 2; ++bj) { const u32x4 w = *(const u32x4*)(HB + r * D + c0 + 128 * bj); rv[m][bj][0] = up4lo(w); rv[m][bj][1] = up4hi(w); } } }
#pragma unroll
            for (int m = 0; m < 4; ++m) { const size_t r = row0 + ai * 128 + m * 16;
#pragma unroll
                for (int bj = 0; bj < 2; ++bj) {
                    const f32x4 h0 = rv[m][bj][0] + acc[ai][bj][m][0], h1 = rv[m][bj][1] + acc[ai][bj][m][1];
                    *(u32x4*)(HB + r * D + c0 + 128 * bj) = pack8(h0, h1);
                    float ss = (h0[0] * h0[0] + h0[1] * h0[1]) + (h0[2] * h0[2] + h0[3] * h0[3]) + (h1[0] * h1[0] + h1[1] * h1[1]) + (h1[2] * h1[2] + h1[3] * h1[3]);
                    ss += __shfl_xor(ss, 16); ss += __shfl_xor(ss, 32);
                    if (fq == 0) part[r * 64 + 8 * u.pn + 4 * bj + wc] = ss; } }
            asm volatile("" ::: "memory"); }
    }
};
struct EpiUp {
    const LAS float* rstab; bf16_t* O;
    __device__ __forceinline__ void operator()(const f32x4 (&acc)[2][2][4][2], const pg8::Unit& u, int wr, int wc, int fr, int fq) const {
        const int row0 = u.pm * 256 + wr * 64 + fr, c0 = 256 * u.pn + 32 * wc + 8 * fq;
        const LAS float* rt = rstab + u.slot * 256 + wr * 64 + fr;
#pragma unroll
        for (int ai = 0; ai < 2; ++ai) {
#pragma unroll
            for (int m = 0; m < 4; ++m) { const size_t r = row0 + ai * 128 + m * 16; const float rs = rt[ai * 128 + m * 16];
#pragma unroll
                for (int bj = 0; bj < 2; ++bj) { f32x4 a0 = acc[ai][bj][m][0] * rs, a1 = acc[ai][bj][m][1] * rs;
#pragma unroll
                    for (int e = 0; e < 4; ++e) { a0[e] = fmaxf(a0[e], 0.f); a0[e] *= a0[e]; a1[e] = fmaxf(a1[e], 0.f); a1[e] *= a1[e]; }
                    *(u32x4*)(O + r * FF + c0 + 128 * bj) = pack8(a0, a1); } } }
    }
};
struct EpiGlu {
    bf16_t* HB; float* part; bf16_t* O;
    __device__ __forceinline__ void operator()(const f32x4 (&acc)[2][2][4][2], const pg8::Unit& u, int wr, int wc, int fr, int fq) const {
        const int row0 = u.pm * 256 + wr * 64 + fr, ch0 = 128 * u.pn + 32 * wc + 8 * fq;
#pragma unroll
        for (int ai = 0; ai < 2; ++ai) {
            u32x4 rv[4];
#pragma unroll
            for (int m = 0; m < 4; ++m) rv[m] = *(const u32x4*)(HB + (size_t)(row0 + ai * 128 + m * 16) * D + ch0);
#pragma unroll
            for (int m = 0; m < 4; ++m) { const size_t r = row0 + ai * 128 + m * 16;
                f32x4 h0 = up4lo(rv[m]), h1 = up4hi(rv[m]);
#pragma unroll
                for (int e = 0; e < 4; ++e) { h0[e] += acc[ai][0][m][0][e] * __builtin_amdgcn_rcpf(1.0f + __expf(-acc[ai][1][m][0][e])); h1[e] += acc[ai][0][m][1][e] * __builtin_amdgcn_rcpf(1.0f + __expf(-acc[ai][1][m][1][e])); }
                *(u32x4*)(HB + r * D + ch0) = pack8(h0, h1);
                float ss = (h0[0] * h0[0] + h0[1] * h0[1]) + (h0[2] * h0[2] + h0[3] * h0[3]) + (h1[0] * h1[0] + h1[1] * h1[1]) + (h1[2] * h1[2] + h1[3] * h1[3]);
                ss += __shfl_xor(ss, 16); ss += __shfl_xor(ss, 32);
                if (fq == 0) part[r * 64 + 4 * u.pn + wc] = ss; }
            asm volatile("" ::: "memory"); }
    }
};

__device__ __forceinline__ void job_info(KP P_, int j, const float*& src, int& Nsrc, const float*& gain, bf16_t*& dst, int& K, int& k0, int& n0) {
    int mode, ndt; const float* src2 = nullptr; unsigned char* ws = P_->ws;
    if (j < 6144) { src = P_->in[9]; Nsrc = 6144; gain = P_->in[6]; dst = (bf16_t*)(ws + O_WIN); K = 2048; ndt = 96; mode = 1; }
    else if (j < 8192) { j -= 6144; src = P_->in[11]; Nsrc = 2048; gain = nullptr; dst = (bf16_t*)(ws + O_WOUT); K = 2048; ndt = 32; mode = 0; }
    else if (j < 16384) { j -= 8192; src = P_->in[22]; Nsrc = 8192; gain = P_->in[7]; dst = (bf16_t*)(ws + O_WUP0); K = 2048; ndt = 128; mode = 0; }
    else if (j < 24576) { j -= 16384; src = P_->in[23]; Nsrc = 2048; gain = nullptr; dst = (bf16_t*)(ws + O_WDN0); K = 8192; ndt = 32; mode = 0; }
    else if (j < 28672) { j -= 24576; src = P_->in[20]; src2 = P_->in[21]; Nsrc = 2048; gain = nullptr; dst = (bf16_t*)(ws + O_WGLU); K = 2048; ndt = 64; mode = 2; }
    else if (j < 36864) { j -= 28672; src = P_->in[22] + (size_t)2048 * 8192; Nsrc = 8192; gain = P_->in[7] + 2048; dst = (bf16_t*)(ws + O_WUP1); K = 2048; ndt = 128; mode = 0; }
    else { j -= 36864; src = P_->in[23] + (size_t)8192 * 2048; Nsrc = 2048; gain = nullptr; dst = (bf16_t*)(ws + O_WDN1); K = 8192; ndt = 32; mode = 0; }
    const int nb = j % ndt, kc = j / ndt; k0 = kc * 32; n0 = nb * 64;
    int col = n0;
    if (mode == 1) { if (n0 < 4096) { const int pn = n0 >> 8, bj = (n0 >> 7) & 1, j0 = n0 & 127; col = (bj ? 4096 : 2048) + 128 * pn + j0; } else col = n0 - 4096; }
    if (mode == 2) { const int pn = n0 >> 8, bj = (n0 >> 7) & 1, j0 = n0 & 127; col = 128 * pn + j0; if (bj) src = src2; }
    src += col;
}
constexpr int NJOBS = 45056, NJOBS_L0 = 24576, NJOBS_F1 = 31744, NJOBS_F2 = 38912;
__device__ __forceinline__ void convert_jobs(KP kp, int j0, int j1, int widx, int nw, int lane) {
    for (int j = j0 + widx; j < j1; j += nw) {
        const float* src; int Nsrc; const float* gain; bf16_t* dst; int K, k0, n0;
        job_info(kp, j, src, Nsrc, gain, dst, K, k0, n0);
        const float* sp = src + (size_t)k0 * Nsrc + lane;
        float v[32];
#pragma unroll
        for (int i = 0; i < 32; ++i) v[i] = sp[(size_t)i * Nsrc];
        if (gain) {
#pragma unroll
            for (int i = 0; i < 32; ++i) v[i] *= gain[k0 + i]; }
        bf16_t* dp = dst + (size_t)(n0 + lane) * K + k0;
#pragma unroll
        for (int o = 0; o < 4; ++o) { u32x4 w; w.x = pk2(v[8 * o], v[8 * o + 1]); w.y = pk2(v[8 * o + 2], v[8 * o + 3]); w.z = pk2(v[8 * o + 4], v[8 * o + 5]); w.w = pk2(v[8 * o + 6], v[8 * o + 7]);
            *(u32x4*)(dp + 8 * o) = w; }
    }
}
__device__ __forceinline__ void filler_phase(KP kp, int bid, int G, int r, int j0, int j1) {
    kp = launder(kp); bid = opaque_s(bid); G = opaque_s(G);
    const int tid = opaque_v(threadIdx.x), lane = tid & 63, wv = __builtin_amdgcn_readfirstlane(tid >> 6);
    convert_jobs(kp, j0, j1, (bid - r) * 8 + wv, (G - r) * 8, lane);
}
__device__ __forceinline__ void prep_phase(KP kp, LAS unsigned char* lds, int bid, int G) {
    kp = launder(kp); bid = opaque_s(bid); G = opaque_s(G);
    const int tid = opaque_v(threadIdx.x), lane = tid & 63, wave = tid >> 6;
    convert_jobs(kp, 0, 6144, bid * 8 + __builtin_amdgcn_readfirstlane(wave), 8 * G, lane);
    if (false) {
        const int wv = __builtin_amdgcn_readfirstlane(wave);
        for (int j = bid * 8 + wv; j < NJOBS; j += 8 * G) {
            const float* src; int Nsrc; const float* gain; bf16_t* dst; int K, k0, n0;
            job_info(kp, j, src, Nsrc, gain, dst, K, k0, n0);
            const float* sp = src + (size_t)k0 * Nsrc + lane;
            float v[32];
#pragma unroll
            for (int i = 0; i < 32; ++i) v[i] = sp[(size_t)i * Nsrc];
            if (gain) {
#pragma unroll
                for (int i = 0; i < 32; ++i) v[i] *= gain[k0 + i]; }
            bf16_t* dp = dst + (size_t)(n0 + lane) * K + k0;
#pragma unroll
            for (int o = 0; o < 4; ++o) { u32x4 w; w.x = pk2(v[8 * o], v[8 * o + 1]); w.y = pk2(v[8 * o + 2], v[8 * o + 3]); w.z = pk2(v[8 * o + 4], v[8 * o + 5]); w.w = pk2(v[8 * o + 6], v[8 * o + 7]);
                *(u32x4*)(dp + 8 * o) = w; }
        }
    }
    {   const Params P = *launder(kp);
        float* H = (float*)(P.ws + O_H); bf16_t* A = (bf16_t*)(P.ws + O_ABF);
        for (int row = wave * G + bid; row < MP; row += 8 * G) {
            const float* xs = nullptr;
            if (row < MPROMPT) { const int b = row / LP, pos = row % LP; xs = pos < 16 ? P.in[5] + (size_t)pos * D : P.in[0] + ((size_t)b * 2048 + (pos - 16)) * D; }
            else if (row < MV) xs = P.in[1] + (size_t)(row - MPROMPT) * D;
            f32x4 v[8]; float ss = 0.f;
#pragma unroll
            for (int j = 0; j < 8; ++j) { v[j] = xs ? *(const f32x4*)(xs + 4 * lane + 256 * j) : (f32x4){0.f, 0.f, 0.f, 0.f}; ss += (v[j][0] * v[j][0] + v[j][1] * v[j][1]) + (v[j][2] * v[j][2] + v[j][3] * v[j][3]); }
#pragma unroll
            for (int o = 1; o < 64; o <<= 1) ss += __shfl_xor(ss, o);
            const float rs = rsqrtf(ss * (1.0f / D) + EPS);
#pragma unroll
            for (int j = 0; j < 8; ++j) {
                u32x2 w; w.x = pk2(v[j][0] * rs, v[j][1] * rs); w.y = pk2(v[j][2] * rs, v[j][3] * rs); *(u32x2*)(A + (size_t)row * D + 4 * lane + 256 * j) = w; }
        }
    }
    {   const Params P = *launder(kp);
        const int gt = bid * NTHREADS + tid, NT = G * NTHREADS;
        for (int i = gt; i < NG * NST; i += NT) { const int g = i >> 6, p = i & 63;
            const float dt = expf(P.in[14][g]), lr = P.in[12][i], li = P.in[13][i];
            const float mag = expf(lr * dt), are = mag * cosf(li * dt), aim = mag * sinf(li * dt);
            ((f32x2*)(P.ws + O_ABAR))[i] = (f32x2){are, aim};
            const float nr = are - 1.0f, ni = aim, den = lr * lr + li * li, qre = (nr * lr + ni * li) / den, qim = (ni * lr - nr * li) / den;
            const float* bre = P.in[15] + (size_t)i * 16; const float* bim = P.in[16] + (size_t)i * 16;
            bf16_t* BF = (bf16_t*)(P.ws + O_BFR);
#pragma unroll
            for (int ch = 0; ch < 2; ++ch) { f32x4 r0 = *(const f32x4*)(bre + 8 * ch), r1 = *(const f32x4*)(bre + 8 * ch + 4), i0 = *(const f32x4*)(bim + 8 * ch), i1 = *(const f32x4*)(bim + 8 * ch + 4);
                const f32x4 o0 = r0 * qre - i0 * qim, o1 = r1 * qre - i1 * qim, m0 = i0 * qre + r0 * qim, m1 = i1 * qre + r1 * qim;
                const int ln = (p & 31) + 32 * ch, blk = p >> 5;
                *(u32x4*)(BF + ((size_t)(g * 4 + blk) * 64 + ln) * 8) = pack8(o0, o1);
                *(u32x4*)(BF + ((size_t)(g * 4 + 2 + blk) * 64 + ln) * 8) = pack8(m0, m1); }
        }
        for (int i = gt; i < NG * 4 * 64; i += NT) { const int g = i >> 8, kk = (i >> 6) & 3, l = i & 63, c = l & 15, p0 = 16 * kk + 4 * (l >> 4);
            const f32x4 cr = *(const f32x4*)(P.in[17] + ((size_t)g * 16 + c) * 64 + p0), ci = *(const f32x4*)(P.in[18] + ((size_t)g * 16 + c) * 64 + p0);
            u32x4 w; w.x = pk2(cr[0], -ci[0]); w.y = pk2(cr[1], -ci[1]); w.z = pk2(cr[2], -ci[2]); w.w = pk2(cr[3], -ci[3]);
            *(u32x4*)((bf16_t*)(P.ws + O_CFR) + (size_t)i * 8) = w; }
    }
}

__device__ __forceinline__ void unpack8(const u32x4 w, float (&f)[8]) { f[0] = bf_lo(w.x); f[1] = bf_hi(w.x); f[2] = bf_lo(w.y); f[3] = bf_hi(w.y); f[4] = bf_lo(w.z); f[5] = bf_hi(w.z); f[6] = bf_lo(w.w); f[7] = bf_hi(w.w); }
__device__ __forceinline__ void conv_phase(KP kp, int bid, int G) {
    const Params P = *launder(kp); bid = opaque_s(bid); G = opaque_s(G);
    const int tid = opaque_v(threadIdx.x), half = tid >> 8, ch = (tid & 255) * 8;
    bf16_t* BG = (bf16_t*)(P.ws + O_BG); const bf16_t* V = (const bf16_t*)(P.ws + O_V);
    float w0[8], w1[8], w2[8];
#pragma unroll
    for (int e = 0; e < 8; ++e) { w0[e] = P.in[10][ch + e]; w1[e] = P.in[10][D + ch + e]; w2[e] = P.in[10][2 * D + ch + e]; }
    for (int item = half * G + bid; item < MV / 8; item += 2 * G) {
        const int row0 = item * 8; const bool smp = row0 >= MPROMPT;
        const int b = smp ? 0 : row0 / LP, pos0 = smp ? 0 : row0 - b * LP, seq0 = smp ? (row0 - MPROMPT) / 4 : 0;
        u32x4 vq[8], bq[8];
#pragma unroll
        for (int r = 0; r < 8; ++r) { vq[r] = *(const u32x4*)(V + (size_t)(row0 + r) * D + ch); bq[r] = *(const u32x4*)(BG + (size_t)(row0 + r) * D + ch); }
        float vm2[8], vm1[8], sm2[8], sm1[8];
        if (smp) { const float* st = P.in[2] + (size_t)seq0 * 2 * D + ch;
#pragma unroll
            for (int e = 0; e < 8; ++e) { vm2[e] = st[e]; vm1[e] = st[D + e]; sm2[e] = st[2 * D + e]; sm1[e] = st[3 * D + e]; } }
        else if (pos0 == 0) {
#pragma unroll
            for (int e = 0; e < 8; ++e) { vm2[e] = 0.f; vm1[e] = 0.f; sm2[e] = 0.f; sm1[e] = 0.f; } }
        else { unpack8(*(const u32x4*)(V + (size_t)(row0 - 2) * D + ch), vm2); unpack8(*(const u32x4*)(V + (size_t)(row0 - 1) * D + ch), vm1);
#pragma unroll
            for (int e = 0; e < 8; ++e) { sm2[e] = 0.f; sm1[e] = 0.f; } }
#pragma unroll
        for (int r = 0; r < 8; ++r) {
            if (r == 4 && smp) {
                float* o = P.out + OUT_CONVS + (size_t)seq0 * 2 * D + ch;
                *(f32x4*)o = (f32x4){vm2[0], vm2[1], vm2[2], vm2[3]}; *(f32x4*)(o + 4) = (f32x4){vm2[4], vm2[5], vm2[6], vm2[7]};
                *(f32x4*)(o + D) = (f32x4){vm1[0], vm1[1], vm1[2], vm1[3]}; *(f32x4*)(o + D + 4) = (f32x4){vm1[4], vm1[5], vm1[6], vm1[7]};
#pragma unroll
                for (int e = 0; e < 8; ++e) { vm2[e] = sm2[e]; vm1[e] = sm1[e]; } }
            float v[8], bg[8]; unpack8(vq[r], v); unpack8(bq[r], bg);
            f32x4 o0, o1;
#pragma unroll
            for (int e = 0; e < 4; ++e) { o0[e] = bg[e] * (w0[e] * vm2[e] + w1[e] * vm1[e] + w2[e] * v[e]); o1[e] = bg[e + 4] * (w0[e + 4] * vm2[e + 4] + w1[e + 4] * vm1[e + 4] + w2[e + 4] * v[e + 4]); }
            *(u32x4*)(BG + (size_t)(row0 + r) * D + ch) = pack8(o0, o1);
#pragma unroll
            for (int e = 0; e < 8; ++e) { vm2[e] = vm1[e]; vm1[e] = v[e]; } }
        if (smp || pos0 + 8 == LP) { float* o = smp ? P.out + OUT_CONVS + (size_t)(seq0 + 1) * 2 * D + ch : P.out + OUT_CONVP + (size_t)b * 2 * D + ch;
            *(f32x4*)o = (f32x4){vm2[0], vm2[1], vm2[2], vm2[3]}; *(f32x4*)(o + 4) = (f32x4){vm2[4], vm2[5], vm2[6], vm2[7]};
            *(f32x4*)(o + D) = (f32x4){vm1[0], vm1[1], vm1[2], vm1[3]}; *(f32x4*)(o + D + 4) = (f32x4){vm1[4], vm1[5], vm1[6], vm1[7]}; }
    }
}

constexpr int S5_CUT = 44;
constexpr int S5_PITCH = 68, S5_UP = 20, S5_RSQ_BYTES = 2112 * 4, S5_WLDS = 32 * S5_PITCH * 4 + 32 * S5_UP * 4 + 128;
template <int MODE>
__device__ __forceinline__ void s5_job(const Params& P, LAS unsigned char* lds, LAS unsigned char* wl, int lane, int g, int idx, int ck0, int ck1, float& hr, float& hi) {
    constexpr bool SAMPLE = (MODE == 1), LIGHT = (MODE == 2);
    const bf16_t* Hb = (const bf16_t*)(P.ws + O_H); const float* part = (const float*)(P.ws + O_PART); bf16_t* GA = (bf16_t*)(P.ws + O_ABF);
    const int t32 = lane & 31, hlf = lane >> 5, t16 = lane & 15, q = lane >> 4;
    const f32x2 ab = ((const f32x2*)(P.ws + O_ABAR))[g * 64 + lane]; const float ar = ab[0], ai = ab[1];
    bf16x8 Bf[4], Cf[4];
#pragma unroll
    for (int i = 0; i < 4; ++i) { Bf[i] = ((const bf16x8*)(P.ws + O_BFR))[(g * 4 + i) * 64 + lane]; if (!LIGHT) Cf[i] = ((const bf16x8*)(P.ws + O_CFR))[(g * 4 + i) * 64 + lane]; }
    const float* gn = P.in[6] + D;
    const f32x4 gnA0 = *(const f32x4*)(gn + 16 * g + 8 * hlf), gnA1 = *(const f32x4*)(gn + 16 * g + 8 * hlf + 4);
    const f32x4 z4 = (f32x4){0.f, 0.f, 0.f, 0.f};
    const f32x4 dE = LIGHT ? z4 : *(const f32x4*)(P.in[19] + 16 * g + 4 * q);
    const LAS float* rsq = (const LAS float*)lds;
    LAS unsigned* Hp = (LAS unsigned*)wl; LAS float* U = (LAS float*)(wl + 32 * S5_PITCH * 4);
    float c15r = 0.f, c15i = 0.f;
    const int rowbase = SAMPLE ? MPROMPT + 32 * idx : idx * LP;
    f32x4 x0 = z4, x1 = z4;
    { const size_t row = rowbase + 32 * ck0 + t32; const u32x4 w = *(const u32x4*)(Hb + row * D + 16 * g + 8 * hlf); x0 = up4lo(w); x1 = up4hi(w); }
    for (int ck = ck0; ck < ck1; ++ck) {
        const int row0 = rowbase + 32 * ck, nvalid = SAMPLE ? 32 : (LP - 32 * ck < 32 ? LP - 32 * ck : 32);
        float rs;
        if (SAMPLE) { const size_t row = row0 + t32; float ss = 0.f; const f32x4* pp = (const f32x4*)(part + row * 64 + 32 * hlf);
#pragma unroll
            for (int i = 0; i < 8; ++i) { const f32x4 v = pp[i]; ss += (v[0] + v[1]) + (v[2] + v[3]); }
            ss += __shfl_xor(ss, 32); rs = rsqrtf(ss * (1.0f / D) + EPS); }
        else rs = rsq[32 * ck + t32];
        f32x4 u0 = x0 * rs * gnA0, u1 = x1 * rs * gnA1;
        if (!SAMPLE && t32 >= nvalid) { u0 = z4; u1 = z4; }
        if (SAMPLE && hlf == 0) U[t32 * S5_UP + 16] = rs;
        union { u32x4 u; bf16x8 b; } af; af.u = pack8(u0, u1);
        if (!SAMPLE && ck + 1 < ck1) {
            const size_t row = row0 + 32 + t32; const u32x4 w = *(const u32x4*)(Hb + row * D + 16 * g + 8 * hlf); x0 = up4lo(w); x1 = up4hi(w); }
        const f32x16 z16 = {0.f, 0.f, 0.f, 0.f, 0.f, 0.f, 0.f, 0.f, 0.f, 0.f, 0.f, 0.f, 0.f, 0.f, 0.f, 0.f};
        f32x16 R0 = __builtin_amdgcn_mfma_f32_32x32x16_bf16(af.b, Bf[0], z16, 0, 0, 0);
        f32x16 R1 = __builtin_amdgcn_mfma_f32_32x32x16_bf16(af.b, Bf[1], z16, 0, 0, 0);
        f32x16 I0 = __builtin_amdgcn_mfma_f32_32x32x16_bf16(af.b, Bf[2], z16, 0, 0, 0);
        f32x16 I1 = __builtin_amdgcn_mfma_f32_32x32x16_bf16(af.b, Bf[3], z16, 0, 0, 0);
#pragma unroll
        for (int i = 0; i < 16; ++i) {
            auto sr = __builtin_amdgcn_permlane32_swap(__float_as_uint(R0[i]), __float_as_uint(R1[i]), false, false); R0[i] = __uint_as_float(sr[0]); R1[i] = __uint_as_float(sr[1]);
            auto si = __builtin_amdgcn_permlane32_swap(__float_as_uint(I0[i]), __float_as_uint(I1[i]), false, false); I0[i] = __uint_as_float(si[0]); I1[i] = __uint_as_float(si[1]); }
        float h0r[8], h0i[8];
        if (SAMPLE) {
#pragma unroll
            for (int s = 0; s < 8; ++s) { const size_t o = ((size_t)(8 * idx + s) * NG + g) * NST + lane; h0r[s] = P.in[3][o]; h0i[s] = P.in[4][o]; } }
#pragma unroll
        for (int t = 0; t < 32; ++t) {
            const int i = 4 * (t >> 3) + (t & 3); const bool up = (t >> 2) & 1;
            const float bre = up ? R1[i] : R0[i], bim = up ? I1[i] : I0[i];
            if (SAMPLE && (t & 3) == 0) { hr = h0r[t >> 2]; hi = h0i[t >> 2]; }
            const float nr = fmaf(ar, hr, fmaf(-ai, hi, bre)), ni = fmaf(ar, hi, fmaf(ai, hr, bim));
            hr = nr; hi = ni;
            if (!LIGHT) Hp[t * S5_PITCH + lane] = pk2(nr, ni);
            if (MODE == 0 && t == 15) { c15r = nr; c15i = ni; }
            if (SAMPLE && (t & 3) == 3) { const size_t o = ((size_t)(8 * idx + (t >> 2)) * NG + g) * NST + lane; P.out[OUT_RES + o] = nr; P.out[OUT_IMS + o] = ni; }
        }
        if (!LIGHT) {
        asm volatile("s_waitcnt lgkmcnt(0)" ::: "memory");
#pragma unroll
        for (int tb = 0; tb < 2; ++tb) {
            f32x4 y = z4;
#pragma unroll
            for (int kk = 0; kk < 4; ++kk) { const bf16x8 hf = *(const LAS bf16x8*)(Hp + (16 * tb + t16) * S5_PITCH + 16 * kk + 4 * q);
                y = __builtin_amdgcn_mfma_f32_16x16x32_bf16(Cf[kk], hf, y, 0, 0, 0); }
            const int t = 16 * tb + t16;
            if (t < nvalid) { const size_t r2 = row0 + t; const float rs2 = SAMPLE ? U[t * S5_UP + 16] : rsq[32 * ck + t];
                const f32x4 uu = up4(*(const u32x2*)(Hb + r2 * D + 16 * g + 4 * q)) * rs2 * *(const f32x4*)(gn + 16 * g + 4 * q);
                f32x4 o;
#pragma unroll
                for (int e = 0; e < 4; ++e) { const float yy = y[e] + dE[e] * uu[e];
                    const float z = 1.5957691216057308f * (yy + 0.044715f * yy * yy * yy); o[e] = yy * __builtin_amdgcn_rcpf(1.0f + __expf(-z)); }
                u32x2 w; w.x = pk2(o[0], o[1]); w.y = pk2(o[2], o[3]);
                *(u32x2*)(GA + r2 * D + 16 * g + 4 * q) = w; }
        }
        asm volatile("s_waitcnt lgkmcnt(0)" ::: "memory");
        }
    }
    if (MODE == 0 && ck1 == 65) { const size_t o = ((size_t)idx * NG + g) * NST + lane; P.out[OUT_REP + o] = c15r; P.out[OUT_IMP + o] = c15i; }
}
__device__ __forceinline__ void s5_phase(KP kp, LAS unsigned char* lds, int bid, int G) {
    const Params P = *launder(kp); bid = opaque_s(bid); G = opaque_s(G);
    const int tid = opaque_v(threadIdx.x), lane = tid & 63, wave = __builtin_amdgcn_readfirstlane(tid >> 6);
    LAS unsigned char* wl = lds + S5_RSQ_BYTES + wave * S5_WLDS;
    const float* part = (const float*)(P.ws + O_PART);
    bool first = true;
    for (int pb = bid; pb < 256 || first; pb += G) {
        const int b = pb >> 6, sg = (pb >> 5) & 1, ck0 = sg ? S5_CUT : 0, ck1 = sg ? 65 : S5_CUT;
        if (pb < 256) {
            LAS float* rsq = (LAS float*)lds; const int rend = 32 * ck1 < LP ? 32 * ck1 : LP;
            for (int r = tid; r < rend; r += NTHREADS) { const f32x4* pp = (const f32x4*)(part + (size_t)(b * LP + r) * 64); float ss = 0.f;
#pragma unroll
                for (int i = 0; i < 16; ++i) { const f32x4 v = pp[i]; ss += (v[0] + v[1]) + (v[2] + v[3]); }
                rsq[r] = rsqrtf(ss * (1.0f / D) + EPS); }
        }
        __syncthreads();
        if (wave < 4) { if (pb < 256) { const int g = 4 * (pb & 31) + wave; float hr = 0.f, hi = 0.f;
            if (ck0 > 0) s5_job<2>(P, lds, wl, lane, g, b, 0, ck0, hr, hi);
            s5_job<0>(P, lds, wl, lane, g, b, ck0, ck1, hr, hi); } }
        if (wave < 4 && first) { for (int sj = bid * 4 + wave; sj < 16 * NG; sj += 4 * G) { float hr = 0.f, hi = 0.f; s5_job<1>(P, lds, wl, lane, sj % NG, sj / NG, 0, 1, hr, hi); } }
        first = false;
        __syncthreads();
    }
}


__device__ __forceinline__ bf16_t* slot_ptr(unsigned char* ws, int slot) { return (bf16_t*)(ws + (slot < 128 ? O_WIN + (size_t)slot * 262144 : O_ABF + (size_t)(slot - 128) * 262144)); }
__device__ __forceinline__ void final_phase(KP kp, int bid, int G) {
    const Params P = *launder(kp); bid = opaque_s(bid); G = opaque_s(G);
    const int tid = opaque_v(threadIdx.x), lane = tid & 63, wave = __builtin_amdgcn_readfirstlane(tid >> 6);
    const bf16_t* H = (const bf16_t*)(P.ws + O_H); const float* gf = P.in[8];
    pg8::StaticOrder SO; SO.init(MP, 2048, G, 0, SPLIT_DN);
    const bool split = !(SO.nwg % G == 0 || (long)(SO.nwg % G) * SPLIT_DN > G);
    const int ntail = split ? SO.nwg - SO.nfull : 0;
    for (int row = wave * G + bid; row < MV; row += 8 * G) {
        float* o;
        if (row < MPROMPT) { const int b = row / LP, pos = row % LP; if (pos < 16) continue; o = P.out + OUT_YP + ((size_t)b * 2048 + (pos - 16)) * D; }
        else o = P.out + OUT_YS + (size_t)(row - MPROMPT) * D;
        f32x4 v[8];
#pragma unroll
        for (int j = 0; j < 8; ++j) v[j] = up4(*(const u32x2*)(H + (size_t)row * D + 4 * lane + 256 * j));
        const int pm = row >> 8, rl = row & 255;
        for (int tu = 0; tu < ntail; ++tu) { pg8::Unit u; SO.map(SO.nfull + tu, u);
            if (u.pm == pm) { f32x4 a = (f32x4){0.f, 0.f, 0.f, 0.f};
                for (int s2 = 0; s2 < SPLIT_DN; ++s2) a += up4(*(const u32x2*)(slot_ptr(P.ws, tu * SPLIT_DN + s2) + (size_t)rl * 256 + 4 * lane));
#pragma unroll
                for (int j = 0; j < 8; ++j) if (j == u.pn) v[j] += a; } }
        float ss = 0.f;
#pragma unroll
        for (int j = 0; j < 8; ++j) ss += (v[j][0] * v[j][0] + v[j][1] * v[j][1]) + (v[j][2] * v[j][2] + v[j][3] * v[j][3]);
#pragma unroll
        for (int of = 1; of < 64; of <<= 1) ss += __shfl_xor(ss, of);
        const float rs = rsqrtf(ss * (1.0f / D) + EPS);
#pragma unroll
        for (int j = 0; j < 8; ++j) { const f32x4 gg = *(const f32x4*)(gf + 4 * lane + 256 * j); *(f32x4*)(o + 4 * lane + 256 * j) = v[j] * rs * gg; }
    }
}
struct EpiAll {
    int mode; bf16_t* H; float* part; bf16_t* O; bf16_t* O2; unsigned char* ws; KP kp; const LAS float* rstab;
    __device__ __forceinline__ void operator()(const f32x4 (&acc)[2][2][4][2], const pg8::Unit& u, int wr, int wc, int fr, int fq) const {
        if (u.ks >= 0) {
            bf16_t* Pp = slot_ptr(ws, u.slot) + (size_t)(wr * 64 + fr) * 256 + 32 * wc + 8 * fq;
#pragma unroll
            for (int ai = 0; ai < 2; ++ai)
#pragma unroll
                for (int m = 0; m < 4; ++m)
#pragma unroll
                    for (int bj = 0; bj < 2; ++bj) { bf16_t* p = Pp + (size_t)(ai * 128 + m * 16) * 256 + 128 * bj; *(u32x4*)p = pack8(acc[ai][bj][m][0], acc[ai][bj][m][1]); }
        }
        else if (mode == 0) { EpiG1 e{O, O2}; e(acc, u, wr, wc, fr, fq); }
        else if (mode == 1) { EpiRes<true> e{H, part, O, kp}; e(acc, u, wr, wc, fr, fq); }
        else if (mode == 2) { EpiUp e{rstab, O}; e(acc, u, wr, wc, fr, fq); }
        else if (mode == 3) { EpiRes<false> e{H, part, nullptr, kp}; e(acc, u, wr, wc, fr, fq); }
        else { EpiGlu e{H, part, O}; e(acc, u, wr, wc, fr, fq); }
    }
};
__device__ __forceinline__ void reduce_phase(KP kp, int bid, int G, int S, bool wbf) {
    const Params P = *launder(kp); bid = opaque_s(bid); G = opaque_s(G);
    const int tid = opaque_v(threadIdx.x), lane = tid & 63, wave = tid >> 6;
    bf16_t* H = (bf16_t*)(P.ws + O_H); float* part = (float*)(P.ws + O_PART);
    pg8::StaticOrder SO; SO.init(MP, 2048, G, 0, S);
    if (SO.nwg % G == 0 || (long)(SO.nwg % G) * S > G) return;
    const int ntail = SO.nwg - SO.nfull;
    constexpr int RB = 3;
    for (int w0 = wave * G + bid; w0 < ntail * 256; w0 += RB * 8 * G) {
        f32x4 a[RB], res[RB]; int tuv[RB], rv[RB], pmv[RB], pnv[RB];
#pragma unroll
        for (int k = 0; k < RB; ++k) { const int w = w0 + k * 8 * G; const bool ok = w < ntail * 256; const int ww = ok ? w : w0;
            tuv[k] = ww >> 8; rv[k] = ww & 255; pg8::Unit u; SO.map(SO.nfull + tuv[k], u); pmv[k] = u.pm; pnv[k] = ok ? u.pn : -1;
            a[k] = (f32x4){0.f, 0.f, 0.f, 0.f};
            for (int s2 = 0; s2 < S; ++s2) a[k] += up4(*(const u32x2*)(slot_ptr(P.ws, tuv[k] * S + s2) + (size_t)rv[k] * 256 + 4 * lane));
            const size_t off = (size_t)(pmv[k] * 256 + rv[k]) * D + u.pn * 256 + 4 * lane;
            res[k] = wbf ? *(const f32x4*)(xsrc(kp, pmv[k] * 256 + rv[k]) + u.pn * 256 + 4 * lane) : up4(*(const u32x2*)(H + off)); }
#pragma unroll
        for (int k = 0; k < RB; ++k) { if (pnv[k] < 0) continue;
            const size_t row = (size_t)(pmv[k] * 256 + rv[k]);
            const f32x4 h = res[k] + a[k]; { u32x2 o; o.x = pk2(h[0], h[1]); o.y = pk2(h[2], h[3]); *(u32x2*)(H + row * D + pnv[k] * 256 + 4 * lane) = o; }
            float ss = (h[0] * h[0] + h[1] * h[1]) + (h[2] * h[2] + h[3] * h[3]);
            ss += __shfl_xor(ss, 1); ss += __shfl_xor(ss, 2); ss += __shfl_xor(ss, 4);
            if ((lane & 7) == 0) part[row * 64 + 8 * pnv[k] + (lane >> 3)] = ss;
            }
    }
}

#define XB_TMO      128
#define XB_XCNT(j)  (256  + 64 * (j))
#define XB_XSUB(j)  (1280 + 64 * (j))
#define XB_XGEN(j)  (2304 + 64 * (j))
#define XB_TOP      3328
#define XB_TOPGEN   3392
#define XCD_BAR_WORDS 3456
#define XB_SPIN_CAP (1u << 18)
__device__ __forceinline__ unsigned xb_ld(unsigned* p)              { return __hip_atomic_load(p, __ATOMIC_RELAXED, __HIP_MEMORY_SCOPE_AGENT); }
__device__ __forceinline__ unsigned xb_add(unsigned* p, unsigned v) { return __hip_atomic_fetch_add(p, v, __ATOMIC_RELAXED, __HIP_MEMORY_SCOPE_AGENT); }
__device__ __forceinline__ unsigned xb_xcc_id() { return (unsigned)__builtin_amdgcn_s_getreg((3 << 11) | 20) & 0xFu; }
#define XB_SPIN(cond, bar) do { unsigned _sp = 0; while (cond) { __builtin_amdgcn_s_sleep(1); \
    if ((++_sp & 255u) == 0u) { if (xb_ld(&(bar)[XB_TMO])) break; if (_sp > XB_SPIN_CAP) { atomicAdd(&(bar)[XB_TMO], 1u); break; } } } } while (0)
__device__ __forceinline__ void xcd_barrier_complete(unsigned* bar, unsigned x, unsigned G, unsigned& nloc, unsigned& nx) {
    unsigned sum, cnt, mine, sp = 0u;
    for (;;) {
        sum = 0u; cnt = 0u; mine = 0u;
#pragma unroll
        for (unsigned j = 0; j < 16; ++j) { const unsigned c = xb_ld(&bar[XB_XCNT(j)]); sum += c; cnt += (c > 0u) ? 1u : 0u; mine = (j == x) ? c : mine; }
        if (sum == G) break;
        __builtin_amdgcn_s_sleep(1);
        if ((++sp & 255u) == 0u) { if (xb_ld(&bar[XB_TMO])) break; if (sp > XB_SPIN_CAP) { atomicAdd(&bar[XB_TMO], 1u); break; } }
    }
    nloc = mine > 0u ? mine : 1u; nx = cnt > 0u ? cnt : 1u;
}
__device__ __forceinline__ void xcd_barrier(unsigned* bar, volatile LAS unsigned* st) {
    asm volatile("s_waitcnt vmcnt(0)" ::: "memory");
    __syncthreads();
    if (threadIdx.x == 0) {
        __builtin_amdgcn_s_waitcnt(0);
        const unsigned x = xb_xcc_id();
        unsigned nloc = st[0], nx = st[1];
        if (nloc == 0u) { xcd_barrier_complete(bar, x, gridDim.x, nloc, nx); st[0] = nloc; st[1] = nx; }
        const unsigned old = xb_add(&bar[XB_XSUB(x)], 1u);
        const unsigned gen = old / nloc;
        if (old + 1u == (gen + 1u) * nloc) {
            __builtin_amdgcn_fence(__ATOMIC_RELEASE, "agent");
            asm volatile("s_waitcnt vmcnt(0)" ::: "memory");
            const unsigned og = xb_add(&bar[XB_TOP], 1u);
            const unsigned tg = og / nx;
            if (og + 1u == (tg + 1u) * nx) xb_add(&bar[XB_TOPGEN], 1u);
            else XB_SPIN(xb_ld(&bar[XB_TOPGEN]) == tg, bar);
            __builtin_amdgcn_fence(__ATOMIC_ACQUIRE, "agent");
            xb_add(&bar[XB_XGEN(x)], 1u);
            asm volatile("s_waitcnt vmcnt(0)" ::: "memory");
        } else {
            XB_SPIN(xb_ld(&bar[XB_XGEN(x)]) == gen, bar);
            __builtin_amdgcn_fence(__ATOMIC_ACQUIRE, "agent");
            asm volatile("s_waitcnt vmcnt(0)" ::: "memory");
        }
    }
    __syncthreads();
}

__global__ void __launch_bounds__(NTHREADS, 2) fwd_kernel(Params Parg) {
    extern __shared__ __attribute__((aligned(16))) unsigned char shm[];
    LAS unsigned char* lds = (LAS unsigned char*)shm;
    const int bid = blockIdx.x, G = gridDim.x;
    KP kp = (KP)__builtin_amdgcn_kernarg_segment_ptr();
    const int ph_lo = kp->ph_lo, ph_hi = kp->ph_hi;
    volatile LAS unsigned* xst = (volatile LAS unsigned*)(lds + pg8::STAGE_BYTES);
    if (threadIdx.x == 0) { xst[0] = 0u; xst[1] = 0u; (void)xb_add((unsigned*)(kp->ws + O_BAR) + XB_XCNT(xb_xcc_id()), 1u); }
    __syncthreads();
    for (int ph = ph_lo; ph < ph_hi; ++ph) {
        if (ph == 0) prep_phase(kp, lds, bid, G);
        else if (ph == 2) conv_phase(kp, bid, G);
        else if (ph == 8) s5_phase(kp, lds, bid, G);
        else if (ph == 12) final_phase(kp, bid, G);
        else if (ph == 4) reduce_phase(kp, bid, G, SPLIT_G2, true);
        else if (ph == 7) reduce_phase(kp, bid, G, SPLIT_DN, false);
        else {
            size_t oa, ob, oo, oo2 = 0; int N, K, mode, S = 1;
            if (ph == 1) { oa = O_ABF; ob = O_WIN; N = 6144; K = 2048; mode = 0; oo = O_V; oo2 = O_BG; }
            else if (ph == 3) { oa = O_BG; ob = O_WOUT; N = 2048; K = 2048; mode = 1; oo = O_ABF; S = SPLIT_G2; }
            else if (ph == 5) { oa = O_H; ob = O_WUP0; N = 8192; K = 2048; mode = 2; oo = O_ACT; }
            else if (ph == 6) { oa = O_ACT; ob = O_WDN0; N = 2048; K = 8192; mode = 3; oo = 0; S = SPLIT_DN; }
            else if (ph == 9) { oa = O_ABF; ob = O_WGLU; N = 4096; K = 2048; mode = 4; oo = O_ABF2; }
            else if (ph == 10) { oa = O_H; ob = O_WUP1; N = 8192; K = 2048; mode = 2; oo = O_ACT; }
            else { oa = O_ACT; ob = O_WDN1; N = 2048; K = 8192; mode = 3; oo = 0; S = SPLIT_DN; }
            unsigned char* ws = launder(kp)->ws;
            if ((N / 256) * (MP / 256) % G == 0 || (long)((N / 256) * (MP / 256) % G) * S > G) S = 1;
            pg8::Gemm g{(const bf16_t*)(ws + oa), (const bf16_t*)(ws + ob), MP, N, K}; pg8::StaticOrder S_; S_.init(MP, N, G, bid, S);
            LAS float* rstab = (LAS float*)(lds + pg8::STAGE_BYTES + 16);
            if (mode == 2) {
                const int t = opaque_v(threadIdx.x), row = t >> 1, hf = t & 1; const float* part = (const float*)(ws + O_PART);
                pg8::Unit u;
                for (int i = 0; i < RS_UNITS && S_.next(i, u); ++i) { const f32x4* pp = (const f32x4*)(part + (size_t)(u.pm * 256 + row) * 64 + 32 * hf); float ss = 0.f;
#pragma unroll
                    for (int k = 0; k < 8; ++k) { const f32x4 v = pp[k]; ss += (v[0] + v[1]) + (v[2] + v[3]); }
                    ss += __shfl_xor(ss, 1);
                    if (hf == 0) rstab[i * 256 + row] = rsqrtf(ss * (1.0f / D) + EPS); }
                __syncthreads();
            }
            EpiAll E{mode, (bf16_t*)(ws + O_H), (float*)(ws + O_PART), (bf16_t*)(ws + oo), (bf16_t*)(ws + oo2), ws, kp, rstab};
            pg8::gemm_phase(lds, g, S_, E);
            if (ph == 1 || ph == 5 || ph == 9 || ph == 10) { const int r = ((N / 256) * (MP / 256)) % G;
                const int j0 = ph == 1 ? 6144 : (ph == 5 ? 16384 : (ph == 9 ? 28672 : 36864)), j1 = ph == 1 ? 16384 : (ph == 5 ? 28672 : (ph == 9 ? 36864 : 45056));
                if (r == 0) filler_phase(kp, bid, G, 0, j0, j1); else if (bid >= r) filler_phase(kp, bid, G, r, j0, j1); }
        }
        if (ph + 1 < ph_hi) {
            if (ph_hi > 1000) { __syncthreads(); cg::this_grid().sync(); }
            else xcd_barrier((unsigned*)(launder(kp)->ws + O_BAR), xst);
        }
    }
}

constexpr int LDS_BYTES = pg8::STAGE_BYTES + 16 + RS_UNITS * 256 * 4;
extern "C" void kernel_launch(void* const* d_in, const int* in_sizes, int n_in, void* d_out, int out_size, void* d_ws, size_t ws_size, hipStream_t stream) {
    static int grid = 0;
    if (grid == 0) {
        if (n_in != 24 || ws_size < O_END) { fprintf(stderr, "kernel_launch: unexpected n_in %d or ws_size %zu (< %zu)\n", n_in, ws_size, (size_t)O_END); grid = -1; return; }
        int dev = 0, cus = 0, per_cu = 0;
        hipGetDevice(&dev); hipDeviceGetAttribute(&cus, hipDeviceAttributeMultiprocessorCount, dev);
        hipFuncSetAttribute((const void*)fwd_kernel, hipFuncAttributeMaxDynamicSharedMemorySize, LDS_BYTES);
        hipOccupancyMaxActiveBlocksPerMultiprocessor(&per_cu, (const void*)fwd_kernel, NTHREADS, LDS_BYTES);
        if (per_cu < 1) per_cu = 1;
        (void)hipGetLastError();
        grid = cus * 1;
        (void)per_cu;
    }
    if (grid < 0) return;
    if (hipMemsetAsync((char*)d_ws + O_BAR, 0, 16384, stream) != hipSuccess) return;
    Params p{};
    for (int i = 0; i < 24; ++i) p.in[i] = (const float*)d_in[i];
    p.out = (float*)d_out; p.ws = (unsigned char*)d_ws;
#if N_LAUNCH_MODE == 1
    p.ph_lo = 0; p.ph_hi = NPHASES;
    void* args[] = {&p};
    hipError_t e = hipLaunchCooperativeKernel((const void*)fwd_kernel, dim3(grid), dim3(NTHREADS), args, LDS_BYTES, stream);
    if (e != hipSuccess) fprintf(stderr, "cooperative launch failed: %s (grid %d)\n", hipGetErrorString(e), grid);
#else
    for (int ph = 0; ph < NPHASES; ++ph) { if (!((DBG_LAUNCH_MASK >> ph) & 1)) continue; p.ph_lo = ph; p.ph_hi = ph + 1; hipLaunchKernelGGL(fwd_kernel, dim3(grid), dim3(NTHREADS), LDS_BYTES, stream, p); }
#endif
}
```

```cpp
#include <hip/hip_runtime.h>
#include <hip/hip_cooperative_groups.h>
#include <cstdio>
namespace cg = cooperative_groups;

#ifndef PHMASK
#define PHMASK 2047
#endif
#ifndef DBG_LAUNCH_MASK
#define DBG_LAUNCH_MASK 0x1FFF
#endif
#ifndef DBL_PHASE
#define DBL_PHASE -1
#define DBL_REPS 0
#endif
#ifndef N_LAUNCH_MODE
#define N_LAUNCH_MODE 1
#endif

#define LAS __attribute__((address_space(3)))
typedef unsigned short bf16_t;
typedef short bf16x8 __attribute__((ext_vector_type(8)));
typedef float f32x4 __attribute__((ext_vector_type(4)));
typedef float f32x2 __attribute__((ext_vector_type(2)));
typedef float f32x16 __attribute__((ext_vector_type(16)));
typedef unsigned u32x4 __attribute__((ext_vector_type(4)));
typedef unsigned u32x2 __attribute__((ext_vector_type(2)));

constexpr int D = 2048, FF = 8192, LP = 2064, NB = 4, MPROMPT = NB * LP  , NSEQ = 128, MV = MPROMPT + NSEQ * 4  , MP = 8960;
constexpr int NG = 128, NST = 64;
constexpr float EPS = 1e-6f;
constexpr int NTHREADS = 512, NPHASES = 13;
constexpr int RS_UNITS = 8;
constexpr int SPLIT_G2 = 4, SPLIT_DN = 8;

constexpr size_t O_WIN = 0;
constexpr size_t O_WOUT = O_WIN + (size_t)6144 * 2048 * 2;
constexpr size_t O_WUP0 = O_WOUT + (size_t)2048 * 2048 * 2;
constexpr size_t O_WDN0 = O_WUP0 + (size_t)8192 * 2048 * 2;
constexpr size_t O_WGLU = O_WDN0 + (size_t)8192 * 2048 * 2;
constexpr size_t O_WUP1 = O_WGLU + (size_t)4096 * 2048 * 2;
constexpr size_t O_WDN1 = O_WUP1 + (size_t)8192 * 2048 * 2;
constexpr size_t O_H = O_WDN1 + (size_t)8192 * 2048 * 2;
constexpr size_t O_ABF = O_H + (size_t)MP * D * 4;
constexpr size_t O_ACT = O_ABF + (size_t)MP * D * 2;
constexpr size_t O_PART = O_ACT + (size_t)MP * FF * 2;
constexpr size_t O_ABAR = O_PART + (size_t)MP * 64 * 4;
constexpr size_t O_BFR = O_ABAR + (size_t)NG * NST * 8;
constexpr size_t O_CFR = O_BFR + (size_t)NG * 4 * 64 * 16;
constexpr size_t O_BAR = O_CFR + (size_t)NG * 4 * 64 * 16;
constexpr size_t O_END = O_BAR + 16384;
constexpr size_t O_BG = O_ACT;
constexpr size_t O_V = O_ACT + (size_t)MP * D * 2;
constexpr size_t O_ABF2 = O_WUP0;

constexpr size_t OUT_YP = 0, OUT_YS = 16777216, OUT_CONVP = 17825792, OUT_REP = 17842176, OUT_IMP = 17874944, OUT_CONVS = 17907712, OUT_RES = 18432000, OUT_IMS = 19480576;

struct Params { const float* in[24]; float* out; unsigned char* ws; int ph_lo, ph_hi; };
#if defined(__HIP_DEVICE_COMPILE__)
typedef const __attribute__((address_space(4))) Params* KP;
#else
typedef const Params* KP;
#endif
__device__ __forceinline__ KP launder(KP p) { asm volatile("" : "+s"(p)); return p; }
__device__ __forceinline__ int opaque_v(int v) { asm volatile("" : "+v"(v)); return v; }
__device__ __forceinline__ int opaque_s(int v) { asm volatile("" : "+s"(v)); return v; }

typedef __bf16 bf16x2_t __attribute__((ext_vector_type(2)));
__device__ __forceinline__ unsigned pk2(float lo, float hi) { f32x2 v = {lo, hi}; bf16x2_t b = __builtin_convertvector(v, bf16x2_t); return __builtin_bit_cast(unsigned, b); }
__device__ __forceinline__ float bf_lo(unsigned w) { return __uint_as_float(w << 16); }
__device__ __forceinline__ float bf_hi(unsigned w) { return __uint_as_float(w & 0xffff0000u); }

namespace pg8 {
constexpr int BM = 256, BK = 64, HALF = 128, HTB = HALF * BK * 2, STAGE_BYTES = 8 * HTB, NXCD = 8, WGM = 8;
__device__ __forceinline__ int lds_byte(int r, int c) { const int st = (r >> 4) * 2 + (c >> 5), rr = r & 15, cc = c & 31, ob = rr * 64 + cc * 2; return st * 1024 + (ob ^ (((ob >> 9) & 1) << 5)); }
__device__ __forceinline__ void stage_rc(int b, int& R, int& C) { const int st = b / 1024, sb = b % 1024, swz = sb ^ (((sb >> 9) & 1) << 5); R = (st >> 1) * 16 + swz / 64; C = (st & 1) * 32 + (swz % 64) / 2; }
__device__ __forceinline__ int perm32(int rho) { const int n = rho >> 4, i = rho & 15; return 8 * (i >> 2) + 4 * n + (i & 3); }
struct Unit { int pm, pn, ks, slot; };
struct Gemm { const bf16_t* A; const bf16_t* Bt; int M, N, K; };
struct StaticOrder {
    int nM, nN, nwg, G, c, S, nfull;
    __device__ void init(int M, int N, int G_, int c_, int S_) { nM = M / BM; nN = N / BM; nwg = nM * nN; G = G_; c = c_; S = S_; nfull = (S_ > 1) ? (nwg / G_) * G_ : nwg; }
    __device__ void map(int wgid, Unit& u) const {
        { const int q = nwg / NXCD, r = nwg % NXCD, xcd = wgid % NXCD, off = wgid / NXCD; wgid = (xcd < r ? xcd * (q + 1) : r * (q + 1) + (xcd - r) * q) + off; }
        const int nig = WGM * nN, gid = wgid / nig, fm = gid * WGM, gsz = (nM - fm) < WGM ? (nM - fm) : WGM;
        u.pm = fm + ((wgid % nig) % gsz); u.pn = (wgid % nig) / gsz;
    }
    __device__ bool next(int i, Unit& u) const {
        const long L = (long)i * G + c;
        if (L < nfull) { map((int)L, u); u.ks = -1; u.slot = i; return true; }
        const long j = L - nfull; if (j >= (long)(nwg - nfull) * S) return false;
        map(nfull + (int)j / S, u); u.ks = (int)j % S; u.slot = (int)j; return true;
    }
};

template <class Epi>
__device__ __forceinline__ void gemm_phase(LAS unsigned char* lds, const Gemm g, const StaticOrder& S, const Epi& E) {
    const int tid = opaque_v(threadIdx.x), wid = __builtin_amdgcn_readfirstlane(tid >> 6), lane = tid & 63, wr = wid >> 2, wc = wid & 3, fr = lane & 15, fq = lane >> 4;
    const int K = g.K, KS = K / S.S;
    unsigned voffA[2], voffB[2];
#pragma unroll
    for (int i = 0; i < 2; ++i) { int R, C; stage_rc(tid * 16 + i * 8192, R, C); const int Rb = (R & ~31) + perm32(R & 31);
        voffA[i] = (unsigned)(R * K + C) * 2u; voffB[i] = (unsigned)(Rb * K + C) * 2u; }
    const size_t kstep = (size_t)(BK * 2);
    const size_t hstep = (size_t)HALF * K * 2;
    const size_t tstep = 2 * hstep;
    const unsigned ldsw = (unsigned)wid * 1024u;
    const int aoff = lds_byte(wr * 64 + fr, fq * 8), boff = lds_byte(wc * 32 + fr, fq * 8);
#define PG8_SA(b, h) (((b) * 2 + (h)) * HTB)
#define PG8_SB(b, h) ((4 + (b) * 2 + (h)) * HTB)
#define PG8_STAGE(bufoff, gbase, voff) do { _Pragma("unroll") for (int _i = 0; _i < 2; ++_i) \
        __builtin_amdgcn_global_load_lds((const unsigned*)((const char*)(gbase) + (voff)[_i]), (LAS unsigned*)(lds + (bufoff) + ldsw + _i * 8192), 16, 0, 0); } while (0)
#define PG8_LDA(dst, b, h) do { _Pragma("unroll") for (int m = 0; m < 4; ++m) _Pragma("unroll") for (int k = 0; k < 2; ++k) dst[m][k] = *(const LAS bf16x8*)(lds + PG8_SA(b, h) + aoff + m * 2048 + k * 1024); } while (0)
#define PG8_LDB(dst, b, h) do { _Pragma("unroll") for (int n = 0; n < 2; ++n) _Pragma("unroll") for (int k = 0; k < 2; ++k) dst[n][k] = *(const LAS bf16x8*)(lds + PG8_SB(b, h) + boff + n * 2048 + k * 1024); } while (0)
#define PG8_MMA(ai, bj, At, Bt) do { __builtin_amdgcn_s_setprio(1); _Pragma("unroll") for (int m = 0; m < 4; ++m) _Pragma("unroll") for (int n = 0; n < 2; ++n) _Pragma("unroll") for (int k = 0; k < 2; ++k) \
        acc[ai][bj][m][n] = __builtin_amdgcn_mfma_f32_16x16x32_bf16(Bt[n][k], At[m][k], acc[ai][bj][m][n], 0, 0, 0); __builtin_amdgcn_s_setprio(0); } while (0)
#define PG8_WAIT_V(n) asm volatile("s_waitcnt vmcnt(" #n ")" ::: "memory")
#define PG8_WAIT_L(n) asm volatile("s_waitcnt lgkmcnt(" #n ")" ::: "memory")
#define PG8_BAR __builtin_amdgcn_s_barrier()
#define PG8_SCHED __builtin_amdgcn_sched_barrier(0)
    Unit cur, nxt; int ui = 0;
    if (!S.next(0, cur)) return;
    f32x4 acc[2][2][4][2];
#pragma unroll
    for (int a = 0; a < 2; ++a)
#pragma unroll
        for (int b = 0; b < 2; ++b)
#pragma unroll
            for (int m = 0; m < 4; ++m)
#pragma unroll
                for (int n = 0; n < 2; ++n) acc[a][b][m][n] = (f32x4){0.f, 0.f, 0.f, 0.f};
    bf16x8 At[4][2], B0[2][2], B1[2][2];
    size_t koff = cur.ks < 0 ? 0 : (size_t)cur.ks * KS * 2; int nt = (cur.ks < 0 ? K : KS) / BK;
    const char* cA = (const char*)g.A + (size_t)cur.pm * tstep + koff; const char* cB = (const char*)g.Bt + (size_t)cur.pn * tstep + koff;
    PG8_STAGE(PG8_SB(0, 0), cB, voffB); PG8_STAGE(PG8_SA(0, 0), cA, voffA); PG8_STAGE(PG8_SB(0, 1), cB + hstep, voffB); PG8_STAGE(PG8_SA(0, 1), cA + hstep, voffA);
    if (wr == 1) PG8_BAR;
    PG8_WAIT_V(4); PG8_BAR;
    PG8_STAGE(PG8_SB(1, 0), cB + kstep, voffB); PG8_STAGE(PG8_SA(1, 0), cA + kstep, voffA); PG8_STAGE(PG8_SB(1, 1), cB + hstep + kstep, voffB);
    PG8_WAIT_V(6); PG8_BAR;
    for (;;) {
        const bool has_next = S.next(ui + 1, nxt);
        const size_t nkoff = (has_next && nxt.ks >= 0) ? (size_t)nxt.ks * KS * 2 : 0;
        const char* nA = has_next ? (const char*)g.A + (size_t)nxt.pm * tstep + nkoff : cA; const char* nB = has_next ? (const char*)g.Bt + (size_t)nxt.pn * tstep + nkoff : cB;
        for (int t = 0; t < nt; t += 2) {
            const bool last = (t == nt - 2);
            const char* a1 = cA + (size_t)(t + 1) * kstep;
            const char* a2 = last ? nA : cA + (size_t)(t + 2) * kstep; const char* b2 = last ? nB : cB + (size_t)(t + 2) * kstep;
            const char* a3 = a2 + kstep; const char* b3 = b2 + kstep;
            PG8_LDB(B0, 0, 0); PG8_SCHED; PG8_LDA(At, 0, 0); PG8_STAGE(PG8_SA(1, 1), a1 + hstep, voffA);
            PG8_WAIT_L(8); PG8_BAR; PG8_WAIT_L(0); PG8_MMA(0, 0, At, B0); PG8_BAR; PG8_SCHED;
            PG8_LDB(B1, 0, 1); PG8_STAGE(PG8_SB(0, 0), b2, voffB);
            PG8_BAR; PG8_WAIT_L(0); PG8_MMA(0, 1, At, B1); PG8_BAR;
            PG8_LDA(At, 0, 1); PG8_STAGE(PG8_SA(0, 0), a2, voffA);
            PG8_BAR; PG8_WAIT_L(0); PG8_MMA(1, 0, At, B0); PG8_BAR; PG8_SCHED;
            PG8_STAGE(PG8_SB(0, 1), b2 + hstep, voffB);
            PG8_WAIT_V(6); PG8_BAR; PG8_MMA(1, 1, At, B1); PG8_BAR;
            PG8_LDB(B0, 1, 0); PG8_SCHED; PG8_LDA(At, 1, 0); PG8_STAGE(PG8_SA(0, 1), a2 + hstep, voffA);
            PG8_WAIT_L(8); PG8_BAR; PG8_WAIT_L(0); PG8_MMA(0, 0, At, B0); PG8_BAR; PG8_SCHED;
            PG8_LDB(B1, 1, 1); PG8_STAGE(PG8_SB(1, 0), b3, voffB);
            PG8_BAR; PG8_WAIT_L(0); PG8_MMA(0, 1, At, B1); PG8_BAR;
            PG8_LDA(At, 1, 1); PG8_STAGE(PG8_SA(1, 0), a3, voffA);
            PG8_BAR; PG8_WAIT_L(0); PG8_MMA(1, 0, At, B0); PG8_BAR; PG8_SCHED;
            PG8_STAGE(PG8_SB(1, 1), b3 + hstep, voffB);
            PG8_WAIT_V(6); PG8_BAR; PG8_MMA(1, 1, At, B1); PG8_BAR;
        }
        E(acc, cur, wr, wc, fr, fq);
        if (!has_next) break;
#pragma unroll
        for (int a = 0; a < 2; ++a)
#pragma unroll
            for (int b = 0; b < 2; ++b)
#pragma unroll
                for (int m = 0; m < 4; ++m)
#pragma unroll
                    for (int n = 0; n < 2; ++n) acc[a][b][m][n] = (f32x4){0.f, 0.f, 0.f, 0.f};
        cur = nxt; cA = nA; cB = nB; ++ui; nt = (cur.ks < 0 ? K : KS) / BK;
    }
    PG8_WAIT_V(0);
    if (wr == 0) PG8_BAR;
    PG8_BAR;
#undef PG8_SA
#undef PG8_SB
#undef PG8_STAGE
#undef PG8_LDA
#undef PG8_LDB
#undef PG8_MMA
#undef PG8_WAIT_V
#undef PG8_WAIT_L
#undef PG8_BAR
#undef PG8_SCHED
}
}

__device__ __forceinline__ f32x4 up4lo(const u32x4 w) { return (f32x4){bf_lo(w.x), bf_hi(w.x), bf_lo(w.y), bf_hi(w.y)}; }
__device__ __forceinline__ f32x4 up4hi(const u32x4 w) { return (f32x4){bf_lo(w.z), bf_hi(w.z), bf_lo(w.w), bf_hi(w.w)}; }
__device__ __forceinline__ f32x4 up4(const u32x2 w) { return (f32x4){bf_lo(w.x), bf_hi(w.x), bf_lo(w.y), bf_hi(w.y)}; }
__device__ __forceinline__ u32x4 pack8(const f32x4 a, const f32x4 b) { u32x4 w; w.x = pk2(a[0], a[1]); w.y = pk2(a[2], a[3]); w.z = pk2(b[0], b[1]); w.w = pk2(b[2], b[3]); return w; }

struct EpiG1 {
    bf16_t* V; bf16_t* BG;
    __device__ __forceinline__ void operator()(const f32x4 (&acc)[2][2][4][2], const pg8::Unit& u, int wr, int wc, int fr, int fq) const {
        const int row0 = u.pm * 256 + wr * 64 + fr;
        if (u.pn < 16) {
            const int ch0 = 128 * u.pn + 32 * wc + 8 * fq;
#pragma unroll
            for (int ai = 0; ai < 2; ++ai)
#pragma unroll
                for (int m = 0; m < 4; ++m) { const size_t r = row0 + ai * 128 + m * 16;
                    *(u32x4*)(V + r * D + ch0) = pack8(acc[ai][0][m][0] * acc[ai][1][m][0], acc[ai][0][m][1] * acc[ai][1][m][1]); }
        } else {
            const int c0 = 256 * (u.pn - 16) + 32 * wc + 8 * fq;
#pragma unroll
            for (int ai = 0; ai < 2; ++ai)
#pragma unroll
                for (int m = 0; m < 4; ++m) { const size_t r = row0 + ai * 128 + m * 16;
#pragma unroll
                    for (int bj = 0; bj < 2; ++bj) *(u32x4*)(BG + r * D + c0 + 128 * bj) = pack8(acc[ai][bj][m][0], acc[ai][bj][m][1]); }
        }
    }
};
__device__ __forceinline__ const float* xsrc(KP kp, int row) {
    if (row < MPROMPT) { const int b = row / LP, pos = row - b * LP; return pos < 16 ? kp->in[5] + (size_t)pos * D : kp->in[0] + ((size_t)b * 2048 + (pos - 16)) * D; }
    if (row < MV) return kp->in[1] + (size_t)(row - MPROMPT) * D;
    return kp->in[5];
}
template <bool WBF> struct EpiRes {
    bf16_t* HB; float* part; bf16_t* O; KP kp;
    __device__ __forceinline__ void operator()(const f32x4 (&acc)[2][2][4][2], const pg8::Unit& u, int wr, int wc, int fr, int fq) const {
        const int row0 = u.pm * 256 + wr * 64 + fr, c0 = 256 * u.pn + 32 * wc + 8 * fq;
#pragma unroll
        for (int ai = 0; ai < 2; ++ai) {
            f32x4 rv[4][2][2];
#pragma unroll
            for (int m = 0; m < 4; ++m) { const size_t r = row0 + ai * 128 + m * 16;
                if (WBF) { const float* rp = xsrc(kp, (int)r) + c0;
#pragma unroll
                    for (int bj = 0; bj < 2; ++bj) { rv[m][bj][0] = *(const f32x4*)(rp + 128 * bj); rv[m][bj][1] = *(const f32x4*)(rp + 128 * bj + 4); } }
                else {
#pragma unroll
                    for (int bj = 0; bj < 2; ++bj) { const u32x4 w = *(const u32x4*)(HB + r * D + c0 + 128 * bj); rv[m][bj][0] = up4lo(w); rv[m][bj][1] = up4hi(w); } } }
#pragma unroll
            for (int m = 0; m < 4; ++m) { const size_t r = row0 + ai * 128 + m * 16;
#pragma unroll
                for (int bj = 0; bj < 2; ++bj) {
                    const f32x4 h0 = rv[m][bj][0] + acc[ai][bj][m][0], h1 = rv[m][bj][1] + acc[ai][bj][m][1];
                    *(u32x4*)(HB + r * D + c0 + 128 * bj) = pack8(h0, h1);
                    float ss = (h0[0] * h0[0] + h0[1] * h0[1]) + (h0[2] * h0[2] + h0[3] * h0[3]) + (h1[0] * h1[0] + h1[1] * h1[1]) + (h1[2] * h1[2] + h1[3] * h1[3]);
                    ss += __shfl_xor(ss, 16); ss += __shfl_xor(ss, 32);
                    if (fq == 0) part[r * 64 + 8 * u.pn + 4 * bj + wc] = ss; } }
            asm volatile("" ::: "memory"); }
    }
};
struct EpiUp {
    const LAS float* rstab; bf16_t* O;
    __device__ __forceinline__ void operator()(const f32x4 (&acc)[2][2][4][2], const pg8::Unit& u, int wr, int wc, int fr, int fq) const {
        const int row0 = u.pm * 256 + wr * 64 + fr, c0 = 256 * u.pn + 32 * wc + 8 * fq;
        const LAS float* rt = rstab + u.slot * 256 + wr * 64 + fr;
#pragma unroll
        for (int ai = 0; ai < 2; ++ai) {
#pragma unroll
            for (int m = 0; m < 4; ++m) { const size_t r = row0 + ai * 128 + m * 16; const float rs = rt[ai * 128 + m * 16];
#pragma unroll
                for (int bj = 0; bj < 2; ++bj) { f32x4 a0 = acc[ai][bj][m][0] * rs, a1 = acc[ai][bj][m][1] * rs;
#pragma unroll
                    for (int e = 0; e < 4; ++e) { a0[e] = fmaxf(a0[e], 0.f); a0[e] *= a0[e]; a1[e] = fmaxf(a1[e], 0.f); a1[e] *= a1[e]; }
                    *(u32x4*)(O + r * FF + c0 + 128 * bj) = pack8(a0, a1); } } }
    }
};
struct EpiGlu {
    bf16_t* HB; float* part; bf16_t* O;
    __device__ __forceinline__ void operator()(const f32x4 (&acc)[2][2][4][2], const pg8::Unit& u, int wr, int wc, int fr, int fq) const {
        const int row0 = u.pm * 256 + wr * 64 + fr, ch0 = 128 * u.pn + 32 * wc + 8 * fq;
#pragma unroll
        for (int ai = 0; ai < 2; ++ai) {
            u32x4 rv[4];
#pragma unroll
            for (int m = 0; m < 4; ++m) rv[m] = *(const u32x4*)(HB + (size_t)(row0 + ai * 128 + m * 16) * D + ch0);
#pragma unroll
            for (int m = 0; m < 4; ++m) { const size_t r = row0 + ai * 128 + m * 16;
                f32x4 h0 = up4lo(rv[m]), h1 = up4hi(rv[m]);
#pragma unroll
                for (int e = 0; e < 4; ++e) { h0[e] += acc[ai][0][m][0][e] * __builtin_amdgcn_rcpf(1.0f + __expf(-acc[ai][1][m][0][e])); h1[e] += acc[ai][0][m][1][e] * __builtin_amdgcn_rcpf(1.0f + __expf(-acc[ai][1][m][1][e])); }
                *(u32x4*)(HB + r * D + ch0) = pack8(h0, h1);
                float ss = (h0[0] * h0[0] + h0[1] * h0[1]) + (h0[2] * h0[2] + h0[3] * h0[3]) + (h1[0] * h1[0] + h1[1] * h1[1]) + (h1[2] * h1[2] + h1[3] * h1[3]);
                ss += __shfl_xor(ss, 16); ss += __shfl_xor(ss, 32);
                if (fq == 0) part[r * 64 + 4 * u.pn + wc] = ss; }
            asm volatile("" ::: "memory"); }
    }
};

__device__ __forceinline__ void job_info(KP P_, int j, const float*& src, int& Nsrc, const float*& gain, bf16_t*& dst, int& K, int& k0, int& n0) {
    int mode, ndt; const float* src2 = nullptr; unsigned char* ws = P_->ws;
    if (j < 6144) { src = P_->in[9]; Nsrc = 6144; gain = P_->in[6]; dst = (bf16_t*)(ws + O_WIN); K = 2048; ndt = 96; mode = 1; }
    else if (j < 8192) { j -= 6144; src = P_->in[11]; Nsrc = 2048; gain = nullptr; dst = (bf16_t*)(ws + O_WOUT); K = 2048; ndt = 32; mode = 0; }
    else if (j < 16384) { j -= 8192; src = P_->in[22]; Nsrc = 8192; gain = P_->in[7]; dst = (bf16_t*)(ws + O_WUP0); K = 2048; ndt = 128; mode = 0; }
    else if (j < 24576) { j -= 16384; src = P_->in[23]; Nsrc = 2048; gain = nullptr; dst = (bf16_t*)(ws + O_WDN0); K = 8192; ndt = 32; mode = 0; }
    else if (j < 28672) { j -= 24576; src = P_->in[20]; src2 = P_->in[21]; Nsrc = 2048; gain = nullptr; dst = (bf16_t*)(ws + O_WGLU); K = 2048; ndt = 64; mode = 2; }
    else if (j < 36864) { j -= 28672; src = P_->in[22] + (size_t)2048 * 8192; Nsrc = 8192; gain = P_->in[7] + 2048; dst = (bf16_t*)(ws + O_WUP1); K = 2048; ndt = 128; mode = 0; }
    else { j -= 36864; src = P_->in[23] + (size_t)8192 * 2048; Nsrc = 2048; gain = nullptr; dst = (bf16_t*)(ws + O_WDN1); K = 8192; ndt = 32; mode = 0; }
    const int nb = j % ndt, kc = j / ndt; k0 = kc * 32; n0 = nb * 64;
    int col = n0;
    if (mode == 1) { if (n0 < 4096) { const int pn = n0 >> 8, bj = (n0 >> 7) & 1, j0 = n0 & 127; col = (bj ? 4096 : 2048) + 128 * pn + j0; } else col = n0 - 4096; }
    if (mode == 2) { const int pn = n0 >> 8, bj = (n0 >> 7) & 1, j0 = n0 & 127; col = 128 * pn + j0; if (bj) src = src2; }
    src += col;
}
constexpr int NJOBS = 45056, NJOBS_L0 = 24576, NJOBS_F1 = 31744, NJOBS_F2 = 38912;
__device__ __forceinline__ void convert_jobs(KP kp, int j0, int j1, int widx, int nw, int lane) {
    for (int j = j0 + widx; j < j1; j += nw) {
        const float* src; int Nsrc; const float* gain; bf16_t* dst; int K, k0, n0;
        job_info(kp, j, src, Nsrc, gain, dst, K, k0, n0);
        const float* sp = src + (size_t)k0 * Nsrc + lane;
        float v[32];
#pragma unroll
        for (int i = 0; i < 32; ++i) v[i] = sp[(size_t)i * Nsrc];
        if (gain) {
#pragma unroll
            for (int i = 0; i < 32; ++i) v[i] *= gain[k0 + i]; }
        bf16_t* dp = dst + (size_t)(n0 + lane) * K + k0;
#pragma unroll
        for (int o = 0; o < 4; ++o) { u32x4 w; w.x = pk2(v[8 * o], v[8 * o + 1]); w.y = pk2(v[8 * o + 2], v[8 * o + 3]); w.z = pk2(v[8 * o + 4], v[8 * o + 5]); w.w = pk2(v[8 * o + 6], v[8 * o + 7]);
            *(u32x4*)(dp + 8 * o) = w; }
    }
}
__device__ __forceinline__ void filler_phase(KP kp, int bid, int G, int r, int j0, int j1) {
    kp = launder(kp); bid = opaque_s(bid); G = opaque_s(G);
    const int tid = opaque_v(threadIdx.x), lane = tid & 63, wv = __builtin_amdgcn_readfirstlane(tid >> 6);
    convert_jobs(kp, j0, j1, (bid - r) * 8 + wv, (G - r) * 8, lane);
}
__device__ __forceinline__ void prep_phase(KP kp, LAS unsigned char* lds, int bid, int G) {
    kp = launder(kp); bid = opaque_s(bid); G = opaque_s(G);
    const int tid = opaque_v(threadIdx.x), lane = tid & 63, wave = tid >> 6;
    convert_jobs(kp, 0, 6144, bid * 8 + __builtin_amdgcn_readfirstlane(wave), 8 * G, lane);
    if (false) {
        const int wv = __builtin_amdgcn_readfirstlane(wave);
        for (int j = bid * 8 + wv; j < NJOBS; j += 8 * G) {
            const float* src; int Nsrc; const float* gain; bf16_t* dst; int K, k0, n0;
            job_info(kp, j, src, Nsrc, gain, dst, K, k0, n0);
            const float* sp = src + (size_t)k0 * Nsrc + lane;
            float v[32];
#pragma unroll
            for (int i = 0; i < 32; ++i) v[i] = sp[(size_t)i * Nsrc];
            if (gain) {
#pragma unroll
                for (int i = 0; i < 32; ++i) v[i] *= gain[k0 + i]; }
            bf16_t* dp = dst + (size_t)(n0 + lane) * K + k0;
#pragma unroll
            for (int o = 0; o < 4; ++o) { u32x4 w; w.x = pk2(v[8 * o], v[8 * o + 1]); w.y = pk2(v[8 * o + 2], v[8 * o + 3]); w.z = pk2(v[8 * o + 4], v[8 * o + 5]); w.w = pk2(v[8 * o + 6], v[8 * o + 7]);
                *(u32x4*)(dp + 8 * o) = w; }
        }
    }
    {   const Params P = *launder(kp);
        float* H = (float*)(P.ws + O_H); bf16_t* A = (bf16_t*)(P.ws + O_ABF);
        for (int row = wave * G + bid; row < MP; row += 8 * G) {
            const float* xs = nullptr;
            if (row < MPROMPT) { const int b = row / LP, pos = row % LP; xs = pos < 16 ? P.in[5] + (size_t)pos * D : P.in[0] + ((size_t)b * 2048 + (pos - 16)) * D; }
            else if (row < MV) xs = P.in[1] + (size_t)(row - MPROMPT) * D;
            f32x4 v[8]; float ss = 0.f;
#pragma unroll
            for (int j = 0; j < 8; ++j) { v[j] = xs ? *(const f32x4*)(xs + 4 * lane + 256 * j) : (f32x4){0.f, 0.f, 0.f, 0.f}; ss += (v[j][0] * v[j][0] + v[j][1] * v[j][1]) + (v[j][2] * v[j][2] + v[j][3] * v[j][3]); }
#pragma unroll
            for (int o = 1; o < 64; o <<= 1) ss += __shfl_xor(ss, o);
            const float rs = rsqrtf(ss * (1.0f / D) + EPS);
#pragma unroll
            for (int j = 0; j < 8; ++j) {
                u32x2 w; w.x = pk2(v[j][0] * rs, v[j][1] * rs); w.y = pk2(v[j][2] * rs, v[j][3] * rs); *(u32x2*)(A + (size_t)row * D + 4 * lane + 256 * j) = w; }
        }
    }
    {   const Params P = *launder(kp);
        const int gt = bid * NTHREADS + tid, NT = G * NTHREADS;
        for (int i = gt; i < NG * NST; i += NT) { const int g = i >> 6, p = i & 63;
            const float dt = expf(P.in[14][g]), lr = P.in[12][i], li = P.in[13][i];
            const float mag = expf(lr * dt), are = mag * cosf(li * dt), aim = mag * sinf(li * dt);
            ((f32x2*)(P.ws + O_ABAR))[i] = (f32x2){are, aim};
            const float nr = are - 1.0f, ni = aim, den = lr * lr + li * li, qre = (nr * lr + ni * li) / den, qim = (ni * lr - nr * li) / den;
            const float* bre = P.in[15] + (size_t)i * 16; const float* bim = P.in[16] + (size_t)i * 16;
            bf16_t* BF = (bf16_t*)(P.ws + O_BFR);
#pragma unroll
            for (int ch = 0; ch < 2; ++ch) { f32x4 r0 = *(const f32x4*)(bre + 8 * ch), r1 = *(const f32x4*)(bre + 8 * ch + 4), i0 = *(const f32x4*)(bim + 8 * ch), i1 = *(const f32x4*)(bim + 8 * ch + 4);
                const f32x4 o0 = r0 * qre - i0 * qim, o1 = r1 * qre - i1 * qim, m0 = i0 * qre + r0 * qim, m1 = i1 * qre + r1 * qim;
                const int ln = (p & 31) + 32 * ch, blk = p >> 5;
                *(u32x4*)(BF + ((size_t)(g * 4 + blk) * 64 + ln) * 8) = pack8(o0, o1);
                *(u32x4*)(BF + ((size_t)(g * 4 + 2 + blk) * 64 + ln) * 8) = pack8(m0, m1); }
        }
        for (int i = gt; i < NG * 4 * 64; i += NT) { const int g = i >> 8, kk = (i >> 6) & 3, l = i & 63, c = l & 15, p0 = 16 * kk + 4 * (l >> 4);
            const f32x4 cr = *(const f32x4*)(P.in[17] + ((size_t)g * 16 + c) * 64 + p0), ci = *(const f32x4*)(P.in[18] + ((size_t)g * 16 + c) * 64 + p0);
            u32x4 w; w.x = pk2(cr[0], -ci[0]); w.y = pk2(cr[1], -ci[1]); w.z = pk2(cr[2], -ci[2]); w.w = pk2(cr[3], -ci[3]);
            *(u32x4*)((bf16_t*)(P.ws + O_CFR) + (size_t)i * 8) = w; }
    }
}

__device__ __forceinline__ void unpack8(const u32x4 w, float (&f)[8]) { f[0] = bf_lo(w.x); f[1] = bf_hi(w.x); f[2] = bf_lo(w.y); f[3] = bf_hi(w.y); f[4] = bf_lo(w.z); f[5] = bf_hi(w.z); f[6] = bf_lo(w.w); f[7] = bf_hi(w.w); }
__device__ __forceinline__ void conv_phase(KP kp, int bid, int G) {
    const Params P = *launder(kp); bid = opaque_s(bid); G = opaque_s(G);
    const int tid = opaque_v(threadIdx.x), half = tid >> 8, ch = (tid & 255) * 8;
    bf16_t* BG = (bf16_t*)(P.ws + O_BG); const bf16_t* V = (const bf16_t*)(P.ws + O_V);
    float w0[8], w1[8], w2[8];
#pragma unroll
    for (int e = 0; e < 8; ++e) { w0[e] = P.in[10][ch + e]; w1[e] = P.in[10][D + ch + e]; w2[e] = P.in[10][2 * D + ch + e]; }
    for (int item = half * G + bid; item < MV / 8; item += 2 * G) {
        const int row0 = item * 8; const bool smp = row0 >= MPROMPT;
        const int b = smp ? 0 : row0 / LP, pos0 = smp ? 0 : row0 - b * LP, seq0 = smp ? (row0 - MPROMPT) / 4 : 0;
        u32x4 vq[8], bq[8];
#pragma unroll
        for (int r = 0; r < 8; ++r) { vq[r] = *(const u32x4*)(V + (size_t)(row0 + r) * D + ch); bq[r] = *(const u32x4*)(BG + (size_t)(row0 + r) * D + ch); }
        float vm2[8], vm1[8], sm2[8], sm1[8];
        if (smp) { const float* st = P.in[2] + (size_t)seq0 * 2 * D + ch;
#pragma unroll
            for (int e = 0; e < 8; ++e) { vm2[e] = st[e]; vm1[e] = st[D + e]; sm2[e] = st[2 * D + e]; sm1[e] = st[3 * D + e]; } }
        else if (pos0 == 0) {
#pragma unroll
            for (int e = 0; e < 8; ++e) { vm2[e] = 0.f; vm1[e] = 0.f; sm2[e] = 0.f; sm1[e] = 0.f; } }
        else { unpack8(*(const u32x4*)(V + (size_t)(row0 - 2) * D + ch), vm2); unpack8(*(const u32x4*)(V + (size_t)(row0 - 1) * D + ch), vm1);
#pragma unroll
            for (int e = 0; e < 8; ++e) { sm2[e] = 0.f; sm1[e] = 0.f; } }
#pragma unroll
        for (int r = 0; r < 8; ++r) {
            if (r == 4 && smp) {
                float* o = P.out + OUT_CONVS + (size_t)seq0 * 2 * D + ch;
                *(f32x4*)o = (f32x4){vm2[0], vm2[1], vm2[2], vm2[3]}; *(f32x4*)(o + 4) = (f32x4){vm2[4], vm2[5], vm2[6], vm2[7]};
                *(f32x4*)(o + D) = (f32x4){vm1[0], vm1[1], vm1[2], vm1[3]}; *(f32x4*)(o + D + 4) = (f32x4){vm1[4], vm1[5], vm1[6], vm1[7]};
#pragma unroll
                for (int e = 0; e < 8; ++e) { vm2[e] = sm2[e]; vm1[e] = sm1[e]; } }
            float v[8], bg[8]; unpack8(vq[r], v); unpack8(bq[r], bg);
            f32x4 o0, o1;
#pragma unroll
            for (int e = 0; e < 4; ++e) { o0[e] = bg[e] * (w0[e] * vm2[e] + w1[e] * vm1[e] + w2[e] * v[e]); o1[e] = bg[e + 4] * (w0[e + 4] * vm2[e + 4] + w1[e + 4] * vm1[e + 4] + w2[e + 4] * v[e + 4]); }
            *(u32x4*)(BG + (size_t)(row0 + r) * D + ch) = pack8(o0, o1);
#pragma unroll
            for (int e = 0; e < 8; ++e) { vm2[e] = vm1[e]; vm1[e] = v[e]; } }
        if (smp || pos0 + 8 == LP) { float* o = smp ? P.out + OUT_CONVS + (size_t)(seq0 + 1) * 2 * D + ch : P.out + OUT_CONVP + (size_t)b * 2 * D + ch;
            *(f32x4*)o = (f32x4){vm2[0], vm2[1], vm2[2], vm2[3]}; *(f32x4*)(o + 4) = (f32x4){vm2[4], vm2[5], vm2[6], vm2[7]};
            *(f32x4*)(o + D) = (f32x4){vm1[0], vm1[1], vm1[2], vm1[3]}; *(f32x4*)(o + D + 4) = (f32x4){vm1[4], vm1[5], vm1[6], vm1[7]}; }
    }
}

constexpr int S5_CUT = 44;
constexpr int S5_PITCH = 68, S5_UP = 20, S5_RSQ_BYTES = 2112 * 4, S5_WLDS = 32 * S5_PITCH * 4 + 32 * S5_UP * 4 + 128;
template <int MODE>
__device__ __forceinline__ void s5_job(const Params& P, LAS unsigned char* lds, LAS unsigned char* wl, int lane, int g, int idx, int ck0, int ck1, float& hr, float& hi) {
    constexpr bool SAMPLE = (MODE == 1), LIGHT = (MODE == 2);
    const bf16_t* Hb = (const bf16_t*)(P.ws + O_H); const float* part = (const float*)(P.ws + O_PART); bf16_t* GA = (bf16_t*)(P.ws + O_ABF);
    const int t32 = lane & 31, hlf = lane >> 5, t16 = lane & 15, q = lane >> 4;
    const f32x2 ab = ((const f32x2*)(P.ws + O_ABAR))[g * 64 + lane]; const float ar = ab[0], ai = ab[1];
    bf16x8 Bf[4], Cf[4];
#pragma unroll
    for (int i = 0; i < 4; ++i) { Bf[i] = ((const bf16x8*)(P.ws + O_BFR))[(g * 4 + i) * 64 + lane]; if (!LIGHT) Cf[i] = ((const bf16x8*)(P.ws + O_CFR))[(g * 4 + i) * 64 + lane]; }
    const float* gn = P.in[6] + D;
    const f32x4 gnA0 = *(const f32x4*)(gn + 16 * g + 8 * hlf), gnA1 = *(const f32x4*)(gn + 16 * g + 8 * hlf + 4);
    const f32x4 z4 = (f32x4){0.f, 0.f, 0.f, 0.f};
    const f32x4 dE = LIGHT ? z4 : *(const f32x4*)(P.in[19] + 16 * g + 4 * q);
    const LAS float* rsq = (const LAS float*)lds;
    LAS unsigned* Hp = (LAS unsigned*)wl; LAS float* U = (LAS float*)(wl + 32 * S5_PITCH * 4);
    float c15r = 0.f, c15i = 0.f;
    const int rowbase = SAMPLE ? MPROMPT + 32 * idx : idx * LP;
    f32x4 x0 = z4, x1 = z4;
    { const size_t row = rowbase + 32 * ck0 + t32; const u32x4 w = *(const u32x4*)(Hb + row * D + 16 * g + 8 * hlf); x0 = up4lo(w); x1 = up4hi(w); }
    for (int ck = ck0; ck < ck1; ++ck) {
        const int row0 = rowbase + 32 * ck, nvalid = SAMPLE ? 32 : (LP - 32 * ck < 32 ? LP - 32 * ck : 32);
        float rs;
        if (SAMPLE) { const size_t row = row0 + t32; float ss = 0.f; const f32x4* pp = (const f32x4*)(part + row * 64 + 32 * hlf);
#pragma unroll
            for (int i = 0; i < 8; ++i) { const f32x4 v = pp[i]; ss += (v[0] + v[1]) + (v[2] + v[3]); }
            ss += __shfl_xor(ss, 32); rs = rsqrtf(ss * (1.0f / D) + EPS); }
        else rs = rsq[32 * ck + t32];
        f32x4 u0 = x0 * rs * gnA0, u1 = x1 * rs * gnA1;
        if (!SAMPLE && t32 >= nvalid) { u0 = z4; u1 = z4; }
        if (SAMPLE && hlf == 0) U[t32 * S5_UP + 16] = rs;
        union { u32x4 u; bf16x8 b; } af; af.u = pack8(u0, u1);
        if (!SAMPLE && ck + 1 < ck1) {
            const size_t row = row0 + 32 + t32; const u32x4 w = *(const u32x4*)(Hb + row * D + 16 * g + 8 * hlf); x0 = up4lo(w); x1 = up4hi(w); }
        const f32x16 z16 = {0.f, 0.f, 0.f, 0.f, 0.f, 0.f, 0.f, 0.f, 0.f, 0.f, 0.f, 0.f, 0.f, 0.f, 0.f, 0.f};
        f32x16 R0 = __builtin_amdgcn_mfma_f32_32x32x16_bf16(af.b, Bf[0], z16, 0, 0, 0);
        f32x16 R1 = __builtin_amdgcn_mfma_f32_32x32x16_bf16(af.b, Bf[1], z16, 0, 0, 0);
        f32x16 I0 = __builtin_amdgcn_mfma_f32_32x32x16_bf16(af.b, Bf[2], z16, 0, 0, 0);
        f32x16 I1 = __builtin_amdgcn_mfma_f32_32x32x16_bf16(af.b, Bf[3], z16, 0, 0, 0);
#pragma unroll
        for (int i = 0; i < 16; ++i) {
            auto sr = __builtin_amdgcn_permlane32_swap(__float_as_uint(R0[i]), __float_as_uint(R1[i]), false, false); R0[i] = __uint_as_float(sr[0]); R1[i] = __uint_as_float(sr[1]);
            auto si = __builtin_amdgcn_permlane32_swap(__float_as_uint(I0[i]), __float_as_uint(I1[i]), false, false); I0[i] = __uint_as_float(si[0]); I1[i] = __uint_as_float(si[1]); }
        float h0r[8], h0i[8];
        if (SAMPLE) {
#pragma unroll
            for (int s = 0; s < 8; ++s) { const size_t o = ((size_t)(8 * idx + s) * NG + g) * NST + lane; h0r[s] = P.in[3][o]; h0i[s] = P.in[4][o]; } }
#pragma unroll
        for (int t = 0; t < 32; ++t) {
            const int i = 4 * (t >> 3) + (t & 3); const bool up = (t >> 2) & 1;
            const float bre = up ? R1[i] : R0[i], bim = up ? I1[i] : I0[i];
            if (SAMPLE && (t & 3) == 0) { hr = h0r[t >> 2]; hi = h0i[t >> 2]; }
            const float nr = fmaf(ar, hr, fmaf(-ai, hi, bre)), ni = fmaf(ar, hi, fmaf(ai, hr, bim));
            hr = nr; hi = ni;
            if (!LIGHT) Hp[t * S5_PITCH + lane] = pk2(nr, ni);
            if (MODE == 0 && t == 15) { c15r = nr; c15i = ni; }
            if (SAMPLE && (t & 3) == 3) { const size_t o = ((size_t)(8 * idx + (t >> 2)) * NG + g) * NST + lane; P.out[OUT_RES + o] = nr; P.out[OUT_IMS + o] = ni; }
        }
        if (!LIGHT) {
        asm volatile("s_waitcnt lgkmcnt(0)" ::: "memory");
#pragma unroll
        for (int tb = 0; tb < 2; ++tb) {
            f32x4 y = z4;
#pragma unroll
            for (int kk = 0; kk < 4; ++kk) { const bf16x8 hf = *(const LAS bf16x8*)(Hp + (16 * tb + t16) * S5_PITCH + 16 * kk + 4 * q);
                y = __builtin_amdgcn_mfma_f32_16x16x32_bf16(Cf[kk], hf, y, 0, 0, 0); }
            const int t = 16 * tb + t16;
            if (t < nvalid) { const size_t r2 = row0 + t; const float rs2 = SAMPLE ? U[t * S5_UP + 16] : rsq[32 * ck + t];
                const f32x4 uu = up4(*(const u32x2*)(Hb + r2 * D + 16 * g + 4 * q)) * rs2 * *(const f32x4*)(gn + 16 * g + 4 * q);
                f32x4 o;
#pragma unroll
                for (int e = 0; e < 4; ++e) { const float yy = y[e] + dE[e] * uu[e];
                    const float z = 1.5957691216057308f * (yy + 0.044715f * yy * yy * yy); o[e] = yy * __builtin_amdgcn_rcpf(1.0f + __expf(-z)); }
                u32x2 w; w.x = pk2(o[0], o[1]); w.y = pk2(o[2], o[3]);
                *(u32x2*)(GA + r2 * D + 16 * g + 4 * q) = w; }
        }
        asm volatile("s_waitcnt lgkmcnt(0)" ::: "memory");
        }
    }
    if (MODE == 0 && ck1 == 65) { const size_t o = ((size_t)idx * NG + g) * NST + lane; P.out[OUT_REP + o] = c15r; P.out[OUT_IMP + o] = c15i; }
}
__device__ __forceinline__ void s5_phase(KP kp, LAS unsigned char* lds, int bid, int G) {
    const Params P = *launder(kp); bid = opaque_s(bid); G = opaque_s(G);
    const int tid = opaque_v(threadIdx.x), lane = tid & 63, wave = __builtin_amdgcn_readfirstlane(tid >> 6);
    LAS unsigned char* wl = lds + S5_RSQ_BYTES + wave * S5_WLDS;
    const float* part = (const float*)(P.ws + O_PART);
    bool first = true;
    for (int pb = bid; pb < 256 || first; pb += G) {
        const int b = pb >> 6, sg = (pb >> 5) & 1, ck0 = sg ? S5_CUT : 0, ck1 = sg ? 65 : S5_CUT;
        if (pb < 256) {
            LAS float* rsq = (LAS float*)lds; const int rend = 32 * ck1 < LP ? 32 * ck1 : LP;
            for (int r = tid; r < rend; r += NTHREADS) { const f32x4* pp = (const f32x4*)(part + (size_t)(b * LP + r) * 64); float ss = 0.f;
#pragma unroll
                for (int i = 0; i < 16; ++i) { const f32x4 v = pp[i]; ss += (v[0] + v[1]) + (v[2] + v[3]); }
                rsq[r] = rsqrtf(ss * (1.0f / D) + EPS); }
        }
        __syncthreads();
        if (wave < 4) { if (pb < 256) { const int g = 4 * (pb & 31) + wave; float hr = 0.f, hi = 0.f;
            if (ck0 > 0) s5_job<2>(P, lds, wl, lane, g, b, 0, ck0, hr, hi);
            s5_job<0>(P, lds, wl, lane, g, b, ck0, ck1, hr, hi); } }
        if (wave < 4 && first) { for (int sj = bid * 4 + wave; sj < 16 * NG; sj += 4 * G) { float hr = 0.f, hi = 0.f; s5_job<1>(P, lds, wl, lane, sj % NG, sj / NG, 0, 1, hr, hi); } }
        first = false;
        __syncthreads();
    }
}


__device__ __forceinline__ bf16_t* slot_ptr(unsigned char* ws, int slot) { return (bf16_t*)(ws + (slot < 128 ? O_WIN + (size_t)slot * 262144 : O_ABF + (size_t)(slot - 128) * 262144)); }
__device__ __forceinline__ void final_phase(KP kp, LAS unsigned char* lds, int bid, int G) {
    const Params P = *launder(kp); bid = opaque_s(bid); G = opaque_s(G);
    const int tid = opaque_v(threadIdx.x), lane = tid & 63, wave = __builtin_amdgcn_readfirstlane(tid >> 6);
    const bf16_t* H = (const bf16_t*)(P.ws + O_H); const float* gf = P.in[8];
    pg8::StaticOrder SO; SO.init(MP, 2048, G, 0, SPLIT_DN);
    const bool split = !(SO.nwg % G == 0 || (long)(SO.nwg % G) * SPLIT_DN > G);
    const int ntail = split ? SO.nwg - SO.nfull : 0;
    LAS int* tt = (LAS int*)lds;
    if (tid < MP / 256) { int code = -1; for (int tu = 0; tu < ntail; ++tu) { pg8::Unit u; SO.map(SO.nfull + tu, u); if (u.pm == tid) code = (code == -1) ? 8 * tu + u.pn : -2; } tt[tid] = code; }
    __syncthreads();
    for (int row = wave * G + bid; row < MV; row += 8 * G) {
        float* o;
        if (row < MPROMPT) { const int b = row / LP, pos = row % LP; if (pos < 16) continue; o = P.out + OUT_YP + ((size_t)b * 2048 + (pos - 16)) * D; }
        else o = P.out + OUT_YS + (size_t)(row - MPROMPT) * D;
        f32x4 v[8];
#pragma unroll
        for (int j = 0; j < 8; ++j) v[j] = up4(*(const u32x2*)(H + (size_t)row * D + 4 * lane + 256 * j));
        const int pm = row >> 8, rl = row & 255, code = __builtin_amdgcn_readfirstlane(tt[pm]);
        if (code >= 0) { const int tu = code >> 3, pn = code & 7; f32x4 a = (f32x4){0.f, 0.f, 0.f, 0.f};
            for (int s2 = 0; s2 < SPLIT_DN; ++s2) a += up4(*(const u32x2*)(slot_ptr(P.ws, tu * SPLIT_DN + s2) + (size_t)rl * 256 + 4 * lane));
#pragma unroll
            for (int j = 0; j < 8; ++j) if (j == pn) v[j] += a; }
        else if (code == -2) for (int tu = 0; tu < ntail; ++tu) { pg8::Unit u; SO.map(SO.nfull + tu, u);
            if (u.pm == pm) { f32x4 a = (f32x4){0.f, 0.f, 0.f, 0.f};
                for (int s2 = 0; s2 < SPLIT_DN; ++s2) a += up4(*(const u32x2*)(slot_ptr(P.ws, tu * SPLIT_DN + s2) + (size_t)rl * 256 + 4 * lane));
#pragma unroll
                for (int j = 0; j < 8; ++j) if (j == u.pn) v[j] += a; } }
        float ss = 0.f;
#pragma unroll
        for (int j = 0; j < 8; ++j) ss += (v[j][0] * v[j][0] + v[j][1] * v[j][1]) + (v[j][2] * v[j][2] + v[j][3] * v[j][3]);
#pragma unroll
        for (int of = 1; of < 64; of <<= 1) ss += __shfl_xor(ss, of);
        const float rs = rsqrtf(ss * (1.0f / D) + EPS);
#pragma unroll
        for (int j = 0; j < 8; ++j) { const f32x4 gg = *(const f32x4*)(gf + 4 * lane + 256 * j); *(f32x4*)(o + 4 * lane + 256 * j) = v[j] * rs * gg; }
    }
}
struct EpiAll {
    int mode; bf16_t* H; float* part; bf16_t* O; bf16_t* O2; unsigned char* ws; KP kp; const LAS float* rstab;
    __device__ __forceinline__ void operator()(const f32x4 (&acc)[2][2][4][2], const pg8::Unit& u, int wr, int wc, int fr, int fq) const {
        if (u.ks >= 0) {
            bf16_t* Pp = slot_ptr(ws, u.slot) + (size_t)(wr * 64 + fr) * 256 + 32 * wc + 8 * fq;
#pragma unroll
            for (int ai = 0; ai < 2; ++ai)
#pragma unroll
                for (int m = 0; m < 4; ++m)
#pragma unroll
                    for (int bj = 0; bj < 2; ++bj) { bf16_t* p = Pp + (size_t)(ai * 128 + m * 16) * 256 + 128 * bj; *(u32x4*)p = pack8(acc[ai][bj][m][0], acc[ai][bj][m][1]); }
        }
        else if (mode == 0) { EpiG1 e{O, O2}; e(acc, u, wr, wc, fr, fq); }
        else if (mode == 1) { EpiRes<true> e{H, part, O, kp}; e(acc, u, wr, wc, fr, fq); }
        else if (mode == 2) { EpiUp e{rstab, O}; e(acc, u, wr, wc, fr, fq); }
        else if (mode == 3) { EpiRes<false> e{H, part, nullptr, kp}; e(acc, u, wr, wc, fr, fq); }
        else { EpiGlu e{H, part, O}; e(acc, u, wr, wc, fr, fq); }
    }
};
__device__ __forceinline__ void reduce_phase(KP kp, int bid, int G, int S, bool wbf) {
    const Params P = *launder(kp); bid = opaque_s(bid); G = opaque_s(G);
    const int tid = opaque_v(threadIdx.x), lane = tid & 63, wave = tid >> 6;
    bf16_t* H = (bf16_t*)(P.ws + O_H); float* part = (float*)(P.ws + O_PART);
    pg8::StaticOrder SO; SO.init(MP, 2048, G, 0, S);
    if (SO.nwg % G == 0 || (long)(SO.nwg % G) * S > G) return;
    const int ntail = SO.nwg - SO.nfull;
    constexpr int RB = 3;
    for (int w0 = wave * G + bid; w0 < ntail * 256; w0 += RB * 8 * G) {
        f32x4 a[RB], res[RB]; int tuv[RB], rv[RB], pmv[RB], pnv[RB];
#pragma unroll
        for (int k = 0; k < RB; ++k) { const int w = w0 + k * 8 * G; const bool ok = w < ntail * 256; const int ww = ok ? w : w0;
            tuv[k] = ww >> 8; rv[k] = ww & 255; pg8::Unit u; SO.map(SO.nfull + tuv[k], u); pmv[k] = u.pm; pnv[k] = ok ? u.pn : -1;
            a[k] = (f32x4){0.f, 0.f, 0.f, 0.f};
            for (int s2 = 0; s2 < S; ++s2) a[k] += up4(*(const u32x2*)(slot_ptr(P.ws, tuv[k] * S + s2) + (size_t)rv[k] * 256 + 4 * lane));
            const size_t off = (size_t)(pmv[k] * 256 + rv[k]) * D + u.pn * 256 + 4 * lane;
            res[k] = wbf ? *(const f32x4*)(xsrc(kp, pmv[k] * 256 + rv[k]) + u.pn * 256 + 4 * lane) : up4(*(const u32x2*)(H + off)); }
#pragma unroll
        for (int k = 0; k < RB; ++k) { if (pnv[k] < 0) continue;
            const size_t row = (size_t)(pmv[k] * 256 + rv[k]);
            const f32x4 h = res[k] + a[k]; { u32x2 o; o.x = pk2(h[0], h[1]); o.y = pk2(h[2], h[3]); *(u32x2*)(H + row * D + pnv[k] * 256 + 4 * lane) = o; }
            float ss = (h[0] * h[0] + h[1] * h[1]) + (h[2] * h[2] + h[3] * h[3]);
            ss += __shfl_xor(ss, 1); ss += __shfl_xor(ss, 2); ss += __shfl_xor(ss, 4);
            if ((lane & 7) == 0) part[row * 64 + 8 * pnv[k] + (lane >> 3)] = ss;
            }
    }
}

#define XB_TMO      128
#define XB_XCNT(j)  (256  + 64 * (j))
#define XB_XSUB(j)  (1280 + 64 * (j))
#define XB_XGEN(j)  (2304 + 64 * (j))
#define XB_TOP      3328
#define XB_TOPGEN   3392
#define XCD_BAR_WORDS 3456
#define XB_SPIN_CAP (1u << 18)
__device__ __forceinline__ unsigned xb_ld(unsigned* p)              { return __hip_atomic_load(p, __ATOMIC_RELAXED, __HIP_MEMORY_SCOPE_AGENT); }
__device__ __forceinline__ unsigned xb_add(unsigned* p, unsigned v) { return __hip_atomic_fetch_add(p, v, __ATOMIC_RELAXED, __HIP_MEMORY_SCOPE_AGENT); }
__device__ __forceinline__ unsigned xb_xcc_id() { return (unsigned)__builtin_amdgcn_s_getreg((3 << 11) | 20) & 0xFu; }
#define XB_SPIN(cond, bar) do { unsigned _sp = 0; while (cond) { __builtin_amdgcn_s_sleep(1); \
    if ((++_sp & 255u) == 0u) { if (xb_ld(&(bar)[XB_TMO])) break; if (_sp > XB_SPIN_CAP) { atomicAdd(&(bar)[XB_TMO], 1u); break; } } } } while (0)
__device__ __forceinline__ void xcd_barrier_complete(unsigned* bar, unsigned x, unsigned G, unsigned& nloc, unsigned& nx) {
    unsigned sum, cnt, mine, sp = 0u;
    for (;;) {
        sum = 0u; cnt = 0u; mine = 0u;
#pragma unroll
        for (unsigned j = 0; j < 16; ++j) { const unsigned c = xb_ld(&bar[XB_XCNT(j)]); sum += c; cnt += (c > 0u) ? 1u : 0u; mine = (j == x) ? c : mine; }
        if (sum == G) break;
        __builtin_amdgcn_s_sleep(1);
        if ((++sp & 255u) == 0u) { if (xb_ld(&bar[XB_TMO])) break; if (sp > XB_SPIN_CAP) { atomicAdd(&bar[XB_TMO], 1u); break; } }
    }
    nloc = mine > 0u ? mine : 1u; nx = cnt > 0u ? cnt : 1u;
}
__device__ __forceinline__ void xcd_barrier(unsigned* bar, volatile LAS unsigned* st) {
    asm volatile("s_waitcnt vmcnt(0)" ::: "memory");
    __syncthreads();
    if (threadIdx.x == 0) {
        __builtin_amdgcn_s_waitcnt(0);
        const unsigned x = xb_xcc_id();
        unsigned nloc = st[0], nx = st[1];
        if (nloc == 0u) { xcd_barrier_complete(bar, x, gridDim.x, nloc, nx); st[0] = nloc; st[1] = nx; }
        const unsigned old = xb_add(&bar[XB_XSUB(x)], 1u);
        const unsigned gen = old / nloc;
        if (old + 1u == (gen + 1u) * nloc) {
            __builtin_amdgcn_fence(__ATOMIC_RELEASE, "agent");
            asm volatile("s_waitcnt vmcnt(0)" ::: "memory");
            const unsigned og = xb_add(&bar[XB_TOP], 1u);
            const unsigned tg = og / nx;
            if (og + 1u == (tg + 1u) * nx) xb_add(&bar[XB_TOPGEN], 1u);
            else XB_SPIN(xb_ld(&bar[XB_TOPGEN]) == tg, bar);
            __builtin_amdgcn_fence(__ATOMIC_ACQUIRE, "agent");
            xb_add(&bar[XB_XGEN(x)], 1u);
            asm volatile("s_waitcnt vmcnt(0)" ::: "memory");
        } else {
            XB_SPIN(xb_ld(&bar[XB_XGEN(x)]) == gen, bar);
            __builtin_amdgcn_fence(__ATOMIC_ACQUIRE, "agent");
            asm volatile("s_waitcnt vmcnt(0)" ::: "memory");
        }
    }
    __syncthreads();
}

__global__ void __launch_bounds__(NTHREADS, 2) fwd_kernel(Params Parg) {
    extern __shared__ __attribute__((aligned(16))) unsigned char shm[];
    LAS unsigned char* lds = (LAS unsigned char*)shm;
    const int bid = blockIdx.x, G = gridDim.x;
    KP kp = (KP)__builtin_amdgcn_kernarg_segment_ptr();
    const int ph_lo = kp->ph_lo, ph_hi = kp->ph_hi;
    volatile LAS unsigned* xst = (volatile LAS unsigned*)(lds + pg8::STAGE_BYTES);
    if (threadIdx.x == 0) { xst[0] = 0u; xst[1] = 0u; (void)xb_add((unsigned*)(kp->ws + O_BAR) + XB_XCNT(xb_xcc_id()), 1u); }
    __syncthreads();
    for (int ph = ph_lo; ph < ph_hi; ++ph) {
        if (ph == 0) prep_phase(kp, lds, bid, G);
        else if (ph == 2) conv_phase(kp, bid, G);
        else if (ph == 8) s5_phase(kp, lds, bid, G);
        else if (ph == 12) final_phase(kp, lds, bid, G);
        else if (ph == 4) reduce_phase(kp, bid, G, SPLIT_G2, true);
        else if (ph == 7) reduce_phase(kp, bid, G, SPLIT_DN, false);
        else {
            size_t oa, ob, oo, oo2 = 0; int N, K, mode, S = 1;
            if (ph == 1) { oa = O_ABF; ob = O_WIN; N = 6144; K = 2048; mode = 0; oo = O_V; oo2 = O_BG; }
            else if (ph == 3) { oa = O_BG; ob = O_WOUT; N = 2048; K = 2048; mode = 1; oo = O_ABF; S = SPLIT_G2; }
            else if (ph == 5) { oa = O_H; ob = O_WUP0; N = 8192; K = 2048; mode = 2; oo = O_ACT; }
            else if (ph == 6) { oa = O_ACT; ob = O_WDN0; N = 2048; K = 8192; mode = 3; oo = 0; S = SPLIT_DN; }
            else if (ph == 9) { oa = O_ABF; ob = O_WGLU; N = 4096; K = 2048; mode = 4; oo = O_ABF2; }
            else if (ph == 10) { oa = O_H; ob = O_WUP1; N = 8192; K = 2048; mode = 2; oo = O_ACT; }
            else { oa = O_ACT; ob = O_WDN1; N = 2048; K = 8192; mode = 3; oo = 0; S = SPLIT_DN; }
            unsigned char* ws = launder(kp)->ws;
            if ((N / 256) * (MP / 256) % G == 0 || (long)((N / 256) * (MP / 256) % G) * S > G) S = 1;
            pg8::Gemm g{(const bf16_t*)(ws + oa), (const bf16_t*)(ws + ob), MP, N, K}; pg8::StaticOrder S_; S_.init(MP, N, G, bid, S);
            LAS float* rstab = (LAS float*)(lds + pg8::STAGE_BYTES + 16);
            if (mode == 2) {
                const int t = opaque_v(threadIdx.x), row = t >> 1, hf = t & 1; const float* part = (const float*)(ws + O_PART);
                pg8::Unit u;
                for (int i = 0; i < RS_UNITS && S_.next(i, u); ++i) { const f32x4* pp = (const f32x4*)(part + (size_t)(u.pm * 256 + row) * 64 + 32 * hf); float ss = 0.f;
#pragma unroll
                    for (int k = 0; k < 8; ++k) { const f32x4 v = pp[k]; ss += (v[0] + v[1]) + (v[2] + v[3]); }
                    ss += __shfl_xor(ss, 1);
                    if (hf == 0) rstab[i * 256 + row] = rsqrtf(ss * (1.0f / D) + EPS); }
                __syncthreads();
            }
            EpiAll E{mode, (bf16_t*)(ws + O_H), (float*)(ws + O_PART), (bf16_t*)(ws + oo), (bf16_t*)(ws + oo2), ws, kp, rstab};
            pg8::gemm_phase(lds, g, S_, E);
            if (ph == 1 || ph == 5 || ph == 9 || ph == 10) { const int r = ((N / 256) * (MP / 256)) % G;
                const int j0 = ph == 1 ? 6144 : (ph == 5 ? 16384 : (ph == 9 ? 28672 : 36864)), j1 = ph == 1 ? 16384 : (ph == 5 ? 28672 : (ph == 9 ? 36864 : 45056));
                if (r == 0) filler_phase(kp, bid, G, 0, j0, j1); else if (bid >= r) filler_phase(kp, bid, G, r, j0, j1); }
        }
        if (ph + 1 < ph_hi) {
            if (ph_hi > 1000) { __syncthreads(); cg::this_grid().sync(); }
            else xcd_barrier((unsigned*)(launder(kp)->ws + O_BAR), xst);
        }
    }
}

constexpr int LDS_BYTES = pg8::STAGE_BYTES + 16 + RS_UNITS * 256 * 4;
extern "C" void kernel_launch(void* const* d_in, const int* in_sizes, int n_in, void* d_out, int out_size, void* d_ws, size_t ws_size, hipStream_t stream) {
    static int grid = 0;
    if (grid == 0) {
        if (n_in != 24 || ws_size < O_END) { fprintf(stderr, "kernel_launch: unexpected n_in %d or ws_size %zu (< %zu)\n", n_in, ws_size, (size_t)O_END); grid = -1; return; }
        int dev = 0, cus = 0, per_cu = 0;
        hipGetDevice(&dev); hipDeviceGetAttribute(&cus, hipDeviceAttributeMultiprocessorCount, dev);
        hipFuncSetAttribute((const void*)fwd_kernel, hipFuncAttributeMaxDynamicSharedMemorySize, LDS_BYTES);
        hipOccupancyMaxActiveBlocksPerMultiprocessor(&per_cu, (const void*)fwd_kernel, NTHREADS, LDS_BYTES);
        if (per_cu < 1) per_cu = 1;
        (void)hipGetLastError();
        grid = cus * 1;
        (void)per_cu;
    }
    if (grid < 0) return;
    if (hipMemsetAsync((char*)d_ws + O_BAR, 0, 16384, stream) != hipSuccess) return;
    Params p{};
    for (int i = 0; i < 24; ++i) p.in[i] = (const float*)d_in[i];
    p.out = (float*)d_out; p.ws = (unsigned char*)d_ws;
#if N_LAUNCH_MODE == 1
    p.ph_lo = 0; p.ph_hi = NPHASES;
    void* args[] = {&p};
    hipError_t e = hipLaunchCooperativeKernel((const void*)fwd_kernel, dim3(grid), dim3(NTHREADS), args, LDS_BYTES, stream);
    if (e != hipSuccess) fprintf(stderr, "cooperative launch failed: %s (grid %d)\n", hipGetErrorString(e), grid);
#else
    for (int ph = 0; ph < NPHASES; ++ph) { if (!((DBG_LAUNCH_MASK >> ph) & 1)) continue; p.ph_lo = ph; p.ph_hi = ph + 1; hipLaunchKernelGGL(fwd_kernel, dim3(grid), dim3(NTHREADS), LDS_BYTES, stream, p); }
#endif
}
```
